# Optimizing an MI355X kernel written in HIP

```python
import math
import jax
import jax.numpy as jnp
from jax import lax
import numpy as np

D_MODEL = 2048
BATCH = 4
SEQ = 4096
DEPTH = 4

N_MIXERS = 3
NORM_EPS = 1e-6
MEM_TOKENS = 256
MEM_HEADS = 4
MEM_HEAD_DIM = D_MODEL // 16
MEM_WIDTH = MEM_HEADS * MEM_HEAD_DIM
MIX_WIDTH = D_MODEL - MEM_WIDTH
RET_HEADS = 6
RET_HEAD_DIM = MIX_WIDTH // RET_HEADS
RET_CHUNK = 128
CONV_WIDTH = 3
MOBA_HEADS = 12
MOBA_HEAD_DIM = MIX_WIDTH // MOBA_HEADS
MOBA_BLOCK = 256
MOBA_TOPK = 3
MOBA_Q_CHUNK = 16
D_FF = ((8 * D_MODEL // 3 + 255) // 256) * 256
MIXER_COLS = (4 * MIX_WIDTH, 3 * MIX_WIDTH, 3 * MIX_WIDTH)

kernel_name = 'hybrid_retention_shortconv_moba_trunk'


def rms_norm(x, gain):
    xf = x.astype(jnp.float32)
    y = xf * lax.rsqrt(jnp.mean(xf * xf, axis=-1, keepdims=True) + NORM_EPS)
    return (y * gain.astype(jnp.float32)).astype(x.dtype)


def causal_dwconv3(x, w):
    s = x.shape[1]
    xp = jnp.pad(x, ((0, 0), (CONV_WIDTH - 1, 0), (0, 0)))
    return w[0] * xp[:, :s] + w[1] * xp[:, 1:s + 1] + w[2] * xp[:, 2:s + 2]


def split_heads(t, n_heads):
    b, s, _ = t.shape
    return t.reshape(b, s, n_heads, -1).transpose(0, 2, 1, 3)


def merge_heads(t):
    b, h, s, d = t.shape
    return t.transpose(0, 2, 1, 3).reshape(b, s, h * d)


def alibi_slopes(n):
    def pow2_slopes(m):
        start = 2.0 ** (-8.0 / m)
        return [start ** (i + 1) for i in range(m)]
    if math.log2(n).is_integer():
        s = pow2_slopes(n)
    else:
        c = 2 ** int(math.floor(math.log2(n)))
        s = pow2_slopes(c) + list(alibi_slopes(2 * c))[0::2][: n - c]
    return np.asarray(s, dtype=np.float32)


def chunkwise_retention(q, k, v):
    b, h, s, d = q.shape
    c = RET_CHUNK
    n = s // c
    dt = q.dtype
    lg = jnp.log1p(-jnp.exp2(-5.0 - jnp.arange(h, dtype=jnp.float32)))
    i = jnp.arange(c, dtype=jnp.float32)
    diff = i[:, None] - i[None, :]
    intra = jnp.where(diff >= 0, jnp.exp(jnp.maximum(diff, 0.0)[None] * lg[:, None, None]), 0.0)
    q_decay = jnp.exp((i + 1.0)[None] * lg[:, None])
    k_decay = jnp.exp((c - 1.0 - i)[None] * lg[:, None])
    chunk_decay = jnp.exp(c * lg).astype(dt)
    qc = q.reshape(b, h, n, c, d)
    kc = k.reshape(b, h, n, c, d)
    vc = v.reshape(b, h, n, c, d)
    scores = jnp.einsum('bhncd,bhnmd->bhncm', qc, kc) * intra[:, None].astype(dt)
    y_intra = jnp.einsum('bhncm,bhnme->bhnce', scores, vc)
    kv = jnp.einsum('bhnmd,bhnme->nbhde', kc * k_decay[:, None, :, None].astype(dt), vc)

    def step(state, kv_n):
        return chunk_decay[:, None, None] * state + kv_n, state

    _, s_prev = lax.scan(step, jnp.zeros((b, h, d, d), dt), kv)
    y_cross = jnp.einsum('bhncd,nbhde->bhnce', qc * q_decay[:, None, :, None].astype(dt), s_prev)
    return (y_intra + y_cross).reshape(b, h, s, d)


def retention_mixer(body, gn_gain):
    q, k, v, g = jnp.split(body, 4, axis=-1)
    q, k, v = (split_heads(t, RET_HEADS) for t in (q, k, v))
    y = chunkwise_retention(q, k * RET_HEAD_DIM ** -0.5, v)
    yf = y.astype(jnp.float32)
    yf = yf * lax.rsqrt(jnp.mean(yf * yf, axis=-1, keepdims=True) + NORM_EPS)
    y = (merge_heads(yf) * gn_gain.astype(jnp.float32)).astype(body.dtype)
    return jax.nn.silu(g) * y


def short_conv_mixer(body, conv_w):
    gate_b, gate_c, h = jnp.split(body, 3, axis=-1)
    return gate_b * causal_dwconv3(gate_c * h, conv_w)


def moba_attention(q, k, v, slopes):
    b, h, s, d = q.shape
    n_blk = -(-s // MOBA_BLOCK)
    s_pad = n_blk * MOBA_BLOCK
    pad = ((0, 0), (0, 0), (0, s_pad - s), (0, 0))
    kb = jnp.pad(k, pad).reshape(b, h, n_blk, MOBA_BLOCK, d)
    vb = jnp.pad(v, pad).reshape(b, h, n_blk, MOBA_BLOCK, d)
    k_mean = jnp.mean(kb, axis=3)
    t = jnp.arange(s)
    own = t // MOBA_BLOCK
    gate = jnp.einsum('bhsd,bhnd->bhsn', q, k_mean).astype(jnp.float32)
    past = jnp.arange(n_blk)[None, :] < own[:, None]
    gate = jnp.where(past, gate, -jnp.inf)
    k_eff = min(MOBA_TOPK, n_blk)
    _, top = lax.top_k(gate, k_eff)
    idx = jnp.concatenate([top, jnp.broadcast_to(own.astype(top.dtype)[None, None, :, None], (b, h, s, 1))], axis=-1)
    valid = jnp.concatenate([jnp.arange(k_eff)[None, :] < own[:, None], jnp.ones((s, 1), bool)], axis=-1)
    k1 = k_eff + 1
    n_q = s // MOBA_Q_CHUNK
    q_ch = jnp.moveaxis(q.reshape(b, h, n_q, MOBA_Q_CHUNK, d), 2, 0)
    i_ch = jnp.moveaxis(idx.reshape(b, h, n_q, MOBA_Q_CHUNK, k1), 2, 0)
    t_ch = t.reshape(n_q, MOBA_Q_CHUNK)
    v_ch = valid.reshape(n_q, MOBA_Q_CHUNK, k1)
    offs = jnp.arange(MOBA_BLOCK)
    scale = d ** -0.5
    gather = jax.vmap(jax.vmap(lambda blocks, ids: blocks[ids]))

    def attend(args):
        qc, ic, tc, vmask = args
        kg = gather(kb, ic)
        vg = gather(vb, ic)
        logits = jnp.einsum('bhqd,bhqjsd->bhqjs', qc, kg).astype(jnp.float32) * scale
        key_pos = ic[..., None] * MOBA_BLOCK + offs
        dist = (tc[:, None, None] - key_pos).astype(jnp.float32)
        logits = logits - slopes[:, None, None, None] * dist
        mask = vmask[:, :, None] & (dist >= 0)
        logits = jnp.where(mask, logits, -jnp.inf)
        shp = logits.shape
        p = jax.nn.softmax(logits.reshape(shp[0], shp[1], shp[2], -1), axis=-1).reshape(shp).astype(qc.dtype)
        return jnp.einsum('bhqjs,bhqjsd->bhqd', p, vg)

    out = lax.map(attend, (q_ch, i_ch, t_ch, v_ch))
    return jnp.moveaxis(out, 0, 2).reshape(b, h, s, d)


def moba_mixer(body):
    q, k, v = jnp.split(body, 3, axis=-1)
    q, k, v = (split_heads(t, MOBA_HEADS) for t in (q, k, v))
    slopes = jnp.asarray(alibi_slopes(MOBA_HEADS))
    return merge_heads(moba_attention(q, k, v, slopes))


def memory_attention(q_mem, mem_kv):
    q = split_heads(q_mem, MEM_HEADS)
    k, v = jnp.split(mem_kv, 2, axis=-1)
    k = split_heads(k, MEM_HEADS)
    v = split_heads(v, MEM_HEADS)
    logits = jnp.einsum('bhsd,bhmd->bhsm', q, k).astype(jnp.float32) * MEM_HEAD_DIM ** -0.5
    p = jax.nn.softmax(logits, axis=-1).astype(q.dtype)
    return merge_heads(jnp.einsum('bhsm,bhmd->bhsd', p, v))


def conv_ffn(x, w_up, conv_w, conv_b, w_down):
    h = causal_dwconv3(x @ w_up, conv_w) + conv_b
    g, u = jnp.split(h, 2, axis=-1)
    return (jax.nn.silu(g) * u) @ w_down


def setup_inputs(seed: int = 0) -> dict:
    key = jax.random.key(seed)
    keys = iter(jax.random.split(key, 64))
    f32 = jnp.float32

    def dense(fan_in, fan_out):
        return jax.random.normal(next(keys), (fan_in, fan_out), f32) * fan_in ** -0.5

    def gain(n):
        return 1.0 + 0.02 * jax.random.normal(next(keys), (n,), f32)

    inputs = {
        'x': jax.random.normal(next(keys), (BATCH, SEQ, D_MODEL), f32),
        'mem': jax.random.normal(next(keys), (BATCH, MEM_TOKENS, D_MODEL), f32),
        'mem_norm': gain(D_MODEL),
    }
    for i in range(DEPTH):
        kind = i % N_MIXERS
        p = 'l%d_' % i
        inputs[p + 'norm_mix'] = gain(D_MODEL)
        inputs[p + 'w_in'] = dense(D_MODEL, MIXER_COLS[kind] + MEM_WIDTH)
        if kind == 0:
            inputs[p + 'ret_gn'] = gain(MIX_WIDTH)
        elif kind == 1:
            inputs[p + 'conv_w'] = jax.random.normal(next(keys), (CONV_WIDTH, MIX_WIDTH), f32) * CONV_WIDTH ** -0.5
        inputs[p + 'w_mem_kv'] = dense(D_MODEL, 2 * MEM_WIDTH)
        inputs[p + 'w_o'] = dense(D_MODEL, D_MODEL)
        inputs[p + 'norm_ffn'] = gain(D_MODEL)
        inputs[p + 'ffn_w_up'] = dense(D_MODEL, 2 * D_FF)
        inputs[p + 'ffn_conv_w'] = jax.random.normal(next(keys), (CONV_WIDTH, 2 * D_FF), f32) * CONV_WIDTH ** -0.5
        inputs[p + 'ffn_conv_b'] = 0.01 * jax.random.normal(next(keys), (2 * D_FF,), f32)
        inputs[p + 'ffn_w_down'] = dense(D_FF, D_MODEL)
    inputs['final_norm'] = gain(D_MODEL)
    return inputs


def reference(x, mem, mem_norm,
              l0_norm_mix, l0_w_in, l0_ret_gn, l0_w_mem_kv, l0_w_o, l0_norm_ffn, l0_ffn_w_up, l0_ffn_conv_w, l0_ffn_conv_b, l0_ffn_w_down,
              l1_norm_mix, l1_w_in, l1_conv_w, l1_w_mem_kv, l1_w_o, l1_norm_ffn, l1_ffn_w_up, l1_ffn_conv_w, l1_ffn_conv_b, l1_ffn_w_down,
              l2_norm_mix, l2_w_in, l2_w_mem_kv, l2_w_o, l2_norm_ffn, l2_ffn_w_up, l2_ffn_conv_w, l2_ffn_conv_b, l2_ffn_w_down,
              l3_norm_mix, l3_w_in, l3_ret_gn, l3_w_mem_kv, l3_w_o, l3_norm_ffn, l3_ffn_w_up, l3_ffn_conv_w, l3_ffn_conv_b, l3_ffn_w_down,
              final_norm):
    layers = [
        (l0_norm_mix, l0_w_in, l0_ret_gn, l0_w_mem_kv, l0_w_o, l0_norm_ffn, l0_ffn_w_up, l0_ffn_conv_w, l0_ffn_conv_b, l0_ffn_w_down),
        (l1_norm_mix, l1_w_in, l1_conv_w, l1_w_mem_kv, l1_w_o, l1_norm_ffn, l1_ffn_w_up, l1_ffn_conv_w, l1_ffn_conv_b, l1_ffn_w_down),
        (l2_norm_mix, l2_w_in, None, l2_w_mem_kv, l2_w_o, l2_norm_ffn, l2_ffn_w_up, l2_ffn_conv_w, l2_ffn_conv_b, l2_ffn_w_down),
        (l3_norm_mix, l3_w_in, l3_ret_gn, l3_w_mem_kv, l3_w_o, l3_norm_ffn, l3_ffn_w_up, l3_ffn_conv_w, l3_ffn_conv_b, l3_ffn_w_down),
    ]
    mem_n = rms_norm(mem, mem_norm)
    for i in range(DEPTH):
        norm_mix, w_in, extra, w_mem_kv, w_o, norm_ffn, w_up, cw, cb, w_down = layers[i]
        kind = i % N_MIXERS
        h = rms_norm(x, norm_mix)
        proj = h @ w_in
        body, q_mem = proj[..., :-MEM_WIDTH], proj[..., -MEM_WIDTH:]
        if kind == 0:
            tok = retention_mixer(body, extra)
        elif kind == 1:
            tok = short_conv_mixer(body, extra)
        else:
            tok = moba_mixer(body)
        mem_out = memory_attention(q_mem, mem_n @ w_mem_kv)
        x = x + jnp.concatenate([tok, mem_out], axis=-1) @ w_o
        x = x + conv_ffn(rms_norm(x, norm_ffn), w_up, cw, cb, w_down)
    return rms_norm(x, final_norm)
```

```cpp
#include <hip/hip_runtime.h>
#include <cstdio>
#include <cstdint>
namespace pg8 {
#define PG8_LAS __attribute__((address_space(3)))
typedef unsigned short bf16_t;
typedef short bf16x8 __attribute__((ext_vector_type(8)));
typedef float f32x4 __attribute__((ext_vector_type(4)));
typedef unsigned u32x4 __attribute__((ext_vector_type(4)));
constexpr int BM = 256, BK = 64, HALF = 128, HTB = HALF * BK * 2  , STAGE_BYTES = 8 * HTB, NXCD = 8, WGM = 8;

__host__ __device__ __forceinline__ int lds_byte(int r, int c) { const int st = (r >> 4) * 2 + (c >> 5), rr = r & 15, cc = c & 31, ob = rr * 64 + cc * 2; return st * 1024 + (ob ^ (((ob >> 9) & 1) << 5)); }
__host__ __device__ __forceinline__ void stage_rc(int b, int& R, int& C) { const int st = b / 1024, sb = b % 1024, swz = sb ^ (((sb >> 9) & 1) << 5); R = (st >> 1) * 16 + swz / 64; C = (st & 1) * 32 + (swz % 64) / 2; }
__host__ __device__ __forceinline__ int perm32(int rho) { const int n = rho >> 4, i = rho & 15; return 8 * (i >> 2) + 4 * n + (i & 3); }

struct Unit { int pm, pn; };
struct Gemm { const bf16_t* A; const bf16_t* Bt; int M, N, K; int kst = BK; };

struct StaticOrder {
    int nM, nN, nwg, G, c, wgm;
    __host__ __device__ void init(int M, int N, int G_, int c_, int wgm_ = WGM) { nM = M / BM; nN = N / BM; nwg = nM * nN; G = G_; c = c_; wgm = wgm_; }
    __host__ __device__ bool next(int i, Unit& u) const {
        const long L = (long)i * G + c; if (L >= nwg) return false;
        int wgid = (int)L; { const int q = nwg / NXCD, r = nwg % NXCD, xcd = wgid % NXCD, off = wgid / NXCD; wgid = (xcd < r ? xcd * (q + 1) : r * (q + 1) + (xcd - r) * q) + off; }
        const int nig = wgm * nN, gid = wgid / nig, fm = gid * wgm, gsz = (nM - fm) < wgm ? (nM - fm) : wgm;
        u.pm = fm + ((wgid % nig) % gsz); u.pn = (wgid % nig) / gsz; return true;
    }
    __device__ __forceinline__ void a_ready(const Unit&) const {}
    __device__ __forceinline__ void done(const Unit&) const {}
};
__device__ __forceinline__ unsigned cvt_pk_bf16(float lo, float hi) { unsigned r; asm volatile("v_cvt_pk_bf16_f32 %0, %1, %2" : "=v"(r) : "v"(lo), "v"(hi)); return r; }
constexpr float RMS_EPS = 1e-6f;
__device__ __forceinline__ float ret_lg2g(int h) {
    const unsigned b = h == 0 ? 0xbd3b9ca6u : h == 1 ? 0xbcba1f74u : h == 2 ? 0xbc3963ddu : h == 3 ? 0xbbb906ceu : h == 4 ? 0xbb38d875u : 0xbab8c154u; return __uint_as_float(b); }
constexpr int EPI_DM = 2048;
constexpr float RSQ_FIX = 16777216.0f, RSQ_INV = 1.0f / 16777216.0f;
typedef unsigned long long rsq_t;
constexpr int EPS_SLOT = 6144, EPS_W = 2048;
__device__ __forceinline__ void eps_dma_rowsq(const rsq_t* rowsq, const Unit& u, int wid, int lane, PG8_LAS unsigned char* slotp) {
    if (wid >= 4 && wid < 6) __builtin_amdgcn_global_load_lds((const unsigned*)(rowsq + (size_t)u.pm * BM + (wid - 4) * 128 + 2 * lane), (PG8_LAS unsigned*)(slotp + (wid - 4) * 1024), 16, 0, 0);
}
__device__ __forceinline__ float eps_row_scale(const PG8_LAS unsigned char* slotp, int row_in_tile) {
    typedef unsigned q2_t __attribute__((ext_vector_type(2)));
    const q2_t q = *(const PG8_LAS q2_t*)(slotp + row_in_tile * 8); const float f = __builtin_fmaf((float)q.y, 4294967296.0f, (float)q.x);
    return __builtin_amdgcn_rsqf(f * (RSQ_INV / EPI_DM) + RMS_EPS); }
__device__ __forceinline__ float rsq_scale(const rsq_t* rowsq, int row) { return __builtin_amdgcn_rsqf((float)rowsq[row] * (RSQ_INV / EPI_DM) + RMS_EPS); }
struct EpiScaleBf16 {
    static constexpr bool PERM = true, AFTER_DRAIN = false;
    bf16_t* O; int ldc; const rsq_t* rowsq; int mode, vk_pn0; float* kmean; PG8_LAS unsigned char* eps;
    __device__ __forceinline__ void unit_begin(const Unit& u, int wid, int lane, int slot) const { if (rowsq) eps_dma_rowsq(rowsq, u, wid, lane, eps + slot * EPS_SLOT); }
    __device__ __forceinline__ void operator()(const f32x4 (&acc)[2][2][4][2], const Unit& u, int wr, int wc, int fr, int fq, int slot) const {
        const int row0 = u.pm * BM + wr * 64 + fr, col0 = u.pn * BM + wc * 32 + 8 * fq;
        const int tsel = u.pn - vk_pn0; const bool special = (mode != 0) && tsel >= 0 && tsel < 6;
        const float lg2g = ret_lg2g(tsel);
        f32x4 cs[2][2];
#pragma unroll
        for (int bj = 0; bj < 2; ++bj) { cs[bj][0] = (f32x4){0.f, 0.f, 0.f, 0.f}; cs[bj][1] = cs[bj][0]; }
#pragma unroll
        for (int ai = 0; ai < 2; ++ai)
#pragma unroll
            for (int m = 0; m < 4; ++m) { const int row = row0 + ai * HALF + m * 16; bf16_t* rowp = O + (size_t)row * ldc + col0;
                float s = rowsq ? eps_row_scale(eps + slot * EPS_SLOT, wr * 64 + fr + ai * HALF + m * 16) : 1.0f;
                if (mode == 1 && special) s *= 0.0625f * __builtin_amdgcn_exp2f(lg2g * (float)(127 - (row & 127)));
#pragma unroll
                for (int bj = 0; bj < 2; ++bj) { const f32x4 v0 = acc[ai][bj][m][0] * s, v1 = acc[ai][bj][m][1] * s;
                    if (mode == 2) { cs[bj][0] += v0; cs[bj][1] += v1; }
                    u32x4 w; w.x = cvt_pk_bf16(v0[0], v0[1]); w.y = cvt_pk_bf16(v0[2], v0[3]); w.z = cvt_pk_bf16(v1[0], v1[1]); w.w = cvt_pk_bf16(v1[2], v1[3]);
                    *(u32x4*)(rowp + bj * HALF) = w; } }
        if (mode == 2 && special) {
            const int b = u.pm >> 4, blk = u.pm & 15;
#pragma unroll
            for (int bj = 0; bj < 2; ++bj)
#pragma unroll
                for (int n = 0; n < 2; ++n)
#pragma unroll
                    for (int i = 0; i < 4; ++i) { float c = cs[bj][n][i]; c += __shfl_xor(c, 1); c += __shfl_xor(c, 2); c += __shfl_xor(c, 4); c += __shfl_xor(c, 8);
                        if (fr == 0) { const int cc = tsel * 256 + bj * HALF + wc * 32 + 8 * fq + 4 * n + i;
                            __hip_atomic_fetch_add(kmean + ((size_t)((b * 12 + (cc >> 7)) * 16 + blk)) * 128 + (cc & 127), c * (1.0f / 256.0f), __ATOMIC_RELAXED, __HIP_MEMORY_SCOPE_AGENT); } }
        }
    }
};
struct EpiRes {
    static constexpr bool PERM = true, AFTER_DRAIN = false;
    const bf16_t* base; bf16_t* out; rsq_t* rowsq;
    __device__ __forceinline__ void unit_begin(const Unit&, int, int, int) const {}
    __device__ __forceinline__ void operator()(const f32x4 (&acc)[2][2][4][2], const Unit& u, int wr, int wc, int fr, int fq, int) const {
        const int row0 = u.pm * BM + wr * 64 + fr, col0 = u.pn * BM + wc * 32 + 8 * fq;
        u32x4 bva[2][4][2];
#pragma unroll
        for (int ai = 0; ai < 2; ++ai)
#pragma unroll
            for (int m = 0; m < 4; ++m)
#pragma unroll
                for (int bj = 0; bj < 2; ++bj) bva[ai][m][bj] = *(const u32x4*)(base + (size_t)(row0 + ai * HALF + m * 16) * EPI_DM + col0 + bj * HALF);
#pragma unroll
        for (int ai = 0; ai < 2; ++ai) {
            const u32x4 (&bv)[4][2] = bva[ai];
#pragma unroll
            for (int m = 0; m < 4; ++m) { const int row = row0 + ai * HALF + m * 16; const size_t off = (size_t)row * EPI_DM + col0; float ss = 0.f;
#pragma unroll
                for (int bj = 0; bj < 2; ++bj) { const u32x4 b = bv[m][bj];
                    const f32x4 b0 = (f32x4){__uint_as_float(b.x << 16), __uint_as_float(b.x & 0xffff0000u), __uint_as_float(b.y << 16), __uint_as_float(b.y & 0xffff0000u)};
                    const f32x4 b1 = (f32x4){__uint_as_float(b.z << 16), __uint_as_float(b.z & 0xffff0000u), __uint_as_float(b.w << 16), __uint_as_float(b.w & 0xffff0000u)};
                    const f32x4 v0 = b0 + acc[ai][bj][m][0], v1 = b1 + acc[ai][bj][m][1];
                    ss += (v0[0] * v0[0] + v0[1] * v0[1]) + (v0[2] * v0[2] + v0[3] * v0[3]) + (v1[0] * v1[0] + v1[1] * v1[1]) + (v1[2] * v1[2] + v1[3] * v1[3]);
                    u32x4 w; w.x = cvt_pk_bf16(v0[0], v0[1]); w.y = cvt_pk_bf16(v0[2], v0[3]); w.z = cvt_pk_bf16(v1[0], v1[1]); w.w = cvt_pk_bf16(v1[2], v1[3]);
                    *(u32x4*)(out + off + bj * HALF) = w; }
                ss += __shfl_xor(ss, 16); ss += __shfl_xor(ss, 32);
                if (fq == 0) __hip_atomic_fetch_add(rowsq + row, (rsq_t)(ss * RSQ_FIX), __ATOMIC_RELAXED, __HIP_MEMORY_SCOPE_AGENT); }
            asm volatile("" ::: "memory"); }
    }
};
__device__ __forceinline__ float dpp_ror1(float v) { return __builtin_bit_cast(float, __builtin_amdgcn_update_dpp(__builtin_bit_cast(int, v), __builtin_bit_cast(int, v), 0x121, 0xF, 0xF, false)); }
__device__ __forceinline__ float dpp_ror2(float v) { return __builtin_bit_cast(float, __builtin_amdgcn_update_dpp(__builtin_bit_cast(int, v), __builtin_bit_cast(int, v), 0x122, 0xF, 0xF, false)); }
__device__ __forceinline__ void conv_taps4(f32x4& o, const f32x4& cur, const f32x4& prv, const f32x4& w2, const f32x4& w1, const f32x4& w0, const f32x4& bb) {
    float o0, o1, o2, o3;
    asm("v_fma_f32 %0, %4, %20, %24\n\t"
        "v_fma_f32 %1, %5, %21, %25\n\t"
        "v_fma_f32 %2, %6, %22, %26\n\t"
        "v_fma_f32 %3, %7, %23, %27\n\t"
        "v_fmac_f32_dpp %0, %4, %12 row_shr:1 row_mask:0xf bank_mask:0xf\n\t"
        "v_fmac_f32_dpp %1, %5, %13 row_shr:1 row_mask:0xf bank_mask:0xf\n\t"
        "v_fmac_f32_dpp %2, %6, %14 row_shr:1 row_mask:0xf bank_mask:0xf\n\t"
        "v_fmac_f32_dpp %3, %7, %15 row_shr:1 row_mask:0xf bank_mask:0xf\n\t"
        "v_fmac_f32_dpp %0, %8, %12 row_shl:15 row_mask:0xf bank_mask:0xf\n\t"
        "v_fmac_f32_dpp %1, %9, %13 row_shl:15 row_mask:0xf bank_mask:0xf\n\t"
        "v_fmac_f32_dpp %2, %10, %14 row_shl:15 row_mask:0xf bank_mask:0xf\n\t"
        "v_fmac_f32_dpp %3, %11, %15 row_shl:15 row_mask:0xf bank_mask:0xf\n\t"
        "v_fmac_f32_dpp %0, %4, %16 row_shr:2 row_mask:0xf bank_mask:0xf\n\t"
        "v_fmac_f32_dpp %1, %5, %17 row_shr:2 row_mask:0xf bank_mask:0xf\n\t"
        "v_fmac_f32_dpp %2, %6, %18 row_shr:2 row_mask:0xf bank_mask:0xf\n\t"
        "v_fmac_f32_dpp %3, %7, %19 row_shr:2 row_mask:0xf bank_mask:0xf\n\t"
        "v_fmac_f32_dpp %0, %8, %16 row_shl:14 row_mask:0xf bank_mask:0xf\n\t"
        "v_fmac_f32_dpp %1, %9, %17 row_shl:14 row_mask:0xf bank_mask:0xf\n\t"
        "v_fmac_f32_dpp %2, %10, %18 row_shl:14 row_mask:0xf bank_mask:0xf\n\t"
        "v_fmac_f32_dpp %3, %11, %19 row_shl:14 row_mask:0xf bank_mask:0xf"
        : "=&v"(o0), "=&v"(o1), "=&v"(o2), "=&v"(o3)
        : "v"(cur[0]), "v"(cur[1]), "v"(cur[2]), "v"(cur[3]), "v"(prv[0]), "v"(prv[1]), "v"(prv[2]), "v"(prv[3]),
          "v"(w1[0]), "v"(w1[1]), "v"(w1[2]), "v"(w1[3]), "v"(w0[0]), "v"(w0[1]), "v"(w0[2]), "v"(w0[3]),
          "v"(w2[0]), "v"(w2[1]), "v"(w2[2]), "v"(w2[3]), "v"(bb[0]), "v"(bb[1]), "v"(bb[2]), "v"(bb[3]));
    o[0] = o0; o[1] = o1; o[2] = o2; o[3] = o3;
}
struct EpiUpConv {
    static constexpr bool PERM = true, AFTER_DRAIN = false;
    bf16_t* ACT; int dff; const rsq_t* rowsq; const float* cw; const float* cb; float* halo; PG8_LAS unsigned char* xch; PG8_LAS unsigned char* eps;
    __device__ __forceinline__ void unit_begin(const Unit& u, int wid, int lane, int slot) const {
        PG8_LAS unsigned char* sp = eps + slot * EPS_SLOT;
        eps_dma_rowsq(rowsq, u, wid, lane, sp);
        if (wid < 4) { const float* src = (wid < 3 ? cw + (size_t)wid * 2 * dff : cb) + (lane < 32 ? 0 : dff) + u.pn * HALF + (lane & 31) * 4;
            __builtin_amdgcn_global_load_lds((const unsigned*)src, (PG8_LAS unsigned*)(sp + EPS_W + wid * 1024), 16, 0, 0); }
    }
    __device__ __forceinline__ void operator()(f32x4 (&acc)[2][2][4][2], const Unit& u, int wr, int wc, int fr, int fq, int slot) const {
        const PG8_LAS unsigned char* sp = eps + slot * EPS_SLOT;
        const int N2 = 2 * dff;
        const int row0 = u.pm * BM + wr * 64 + fr, colp = u.pn * BM + wc * 32 + 8 * fq, ch0 = u.pn * HALF + wc * 32 + 8 * fq;
        float rs8[2][4];
#pragma unroll
        for (int ai = 0; ai < 2; ++ai)
#pragma unroll
            for (int m = 0; m < 4; ++m) rs8[ai][m] = eps_row_scale(sp, wr * 64 + fr + ai * HALF + m * 16);
#pragma unroll
        for (int ai = 0; ai < 2; ++ai)
#pragma unroll
            for (int m = 0; m < 4; ++m) { const float s = rs8[ai][m];
#pragma unroll
                for (int bj = 0; bj < 2; ++bj) { acc[ai][bj][m][0] *= s; acc[ai][bj][m][1] *= s; } }
        PG8_LAS float* X = (PG8_LAS float*)xch;
        if (fr >= 14) {
#pragma unroll
            for (int ai = 0; ai < 2; ++ai) { PG8_LAS float* xp = X + (((((ai * 2 + wr) * 4 + wc) * 2 + (fr - 14)) * 4 + fq) * 16);
#pragma unroll
                for (int bj = 0; bj < 2; ++bj) { *(PG8_LAS f32x4*)(xp + (bj * 2 + 0) * 4) = acc[ai][bj][3][0]; *(PG8_LAS f32x4*)(xp + (bj * 2 + 1) * 4) = acc[ai][bj][3][1]; } }
            if (wr == 1) { float* hp = halo + ((size_t)(u.pm * 4 + 2 + (fr - 14))) * N2 + colp;
#pragma unroll
                for (int bj = 0; bj < 2; ++bj) { *(f32x4*)(hp + bj * HALF) = acc[1][bj][3][0]; *(f32x4*)(hp + bj * HALF + 4) = acc[1][bj][3][1]; } }
        }
        if (wr == 0 && fr < 2) { float* hp = halo + ((size_t)(u.pm * 4 + fr)) * N2 + colp;
#pragma unroll
            for (int bj = 0; bj < 2; ++bj) { *(f32x4*)(hp + bj * HALF) = acc[0][bj][0][0]; *(f32x4*)(hp + bj * HALF + 4) = acc[0][bj][0][1]; } }
        asm volatile("s_waitcnt lgkmcnt(0)" ::: "memory"); __builtin_amdgcn_s_barrier(); asm volatile("" ::: "memory");
#pragma unroll
        for (int bj = 0; bj < 2; ++bj)
#pragma unroll
            for (int n = 0; n < 2; ++n) {
                const PG8_LAS float* wp = (const PG8_LAS float*)(sp + EPS_W) + bj * HALF + wc * 32 + 8 * fq + 4 * n;
                const f32x4 w0 = *(const PG8_LAS f32x4*)wp, w1 = *(const PG8_LAS f32x4*)(wp + 256), w2 = *(const PG8_LAS f32x4*)(wp + 512), bb = *(const PG8_LAS f32x4*)(wp + 768);
#pragma unroll
                for (int ai = 1; ai >= 0; --ai) {
                    f32x4 pv = (f32x4){0.f, 0.f, 0.f, 0.f};
                    if (wr == 1 || ai == 1) { const int pai = wr == 1 ? ai : ai - 1, pwr = wr == 1 ? 0 : 1;
                        if (fr >= 14) pv = *(const PG8_LAS f32x4*)(X + (((((pai * 2 + pwr) * 4 + wc) * 2 + (fr - 14)) * 4 + fq) * 16) + (bj * 2 + n) * 4); }
#pragma unroll
                    for (int m = 3; m >= 0; --m) {
                        const f32x4 cur = acc[ai][bj][m][n]; const f32x4 prv = (m > 0) ? acc[ai][bj][m - 1][n] : pv;
                        f32x4 o; conv_taps4(o, cur, prv, w2, w1, w0, bb);
                        acc[ai][bj][m][n] = o;
                        asm volatile("" : "+v"(acc[ai][bj][m][n])); }
                    __builtin_amdgcn_sched_barrier(0);
                }
            }
#pragma unroll
        for (int ai = 0; ai < 2; ++ai)
#pragma unroll
            for (int m = 0; m < 4; ++m) { const f32x4 g0 = acc[ai][0][m][0], g1 = acc[ai][0][m][1], u0 = acc[ai][1][m][0], u1 = acc[ai][1][m][1];
                const f32x4 t0 = g0, t1 = g1; f32x4 e0, e1;
#pragma unroll
                for (int i = 0; i < 4; ++i) { e0[i] = __builtin_amdgcn_exp2f(t0[i]); e1[i] = __builtin_amdgcn_exp2f(t1[i]); }
                const f32x4 d0 = e0 + 1.0f, d1 = e1 + 1.0f; f32x4 r0, r1;
#pragma unroll
                for (int i = 0; i < 4; ++i) { r0[i] = __builtin_amdgcn_rcpf(d0[i]); r1[i] = __builtin_amdgcn_rcpf(d1[i]); }
                const f32x4 a0 = (g0 * u0) * r0, a1 = (g1 * u1) * r1;
                u32x4 w; w.x = cvt_pk_bf16(a0[0], a0[1]); w.y = cvt_pk_bf16(a0[2], a0[3]); w.z = cvt_pk_bf16(a1[0], a1[1]); w.w = cvt_pk_bf16(a1[2], a1[3]);
                *(u32x4*)(ACT + (size_t)(row0 + ai * HALF + m * 16) * dff + ch0) = w;
                __builtin_amdgcn_sched_barrier(0); }
    }
};
struct EpiNull {
    static constexpr bool PERM = true, AFTER_DRAIN = false;
    float* sink;
    __device__ __forceinline__ void unit_begin(const Unit&, int, int, int) const {}
    __device__ __forceinline__ void operator()(const f32x4 (&acc)[2][2][4][2], const Unit& u, int wr, int wc, int fr, int fq, int) const {
        float s = 0.f;
#pragma unroll
        for (int ai = 0; ai < 2; ++ai)
#pragma unroll
            for (int bj = 0; bj < 2; ++bj)
#pragma unroll
                for (int m = 0; m < 4; ++m)
#pragma unroll
                    for (int n = 0; n < 2; ++n) s += acc[ai][bj][m][n][0] + acc[ai][bj][m][n][1] + acc[ai][bj][m][n][2] + acc[ai][bj][m][n][3];
        if (s == 1.2345678e30f) sink[u.pm * 64 + fr] = s;
    }
};
template <class Epi, class Sched, bool ALIGN_EPI = false, bool SP2 = false>
__device__ __forceinline__ void gemm_phase(int wave_s, PG8_LAS unsigned char* lds, const Gemm g, const Sched& S, const Epi& E) {
    int lane_; asm volatile("v_mbcnt_lo_u32_b32 %0, -1, 0\n\tv_mbcnt_hi_u32_b32 %0, -1, %0" : "=v"(lane_)); const int tid_ = wave_s * 64 + lane_;
    const int tid = tid_, wid = __builtin_amdgcn_readfirstlane(tid >> 6), lane = tid & 63, wr = wid >> 2, wc = wid & 3, fr = lane & 15, fq = lane >> 4;
    const int K = g.K, nt = K / BK;
    unsigned voffA[2], voffB[2];
#pragma unroll
    for (int i = 0; i < 2; ++i) { int R, C; stage_rc(tid * 16 + i * 8192, R, C); const int Rb = Epi::PERM ? ((R & ~31) + perm32(R & 31)) : R;
        voffA[i] = (unsigned)(R * K + C) * 2u; voffB[i] = (unsigned)(Rb * K + C) * 2u; }
    const size_t kstep = (size_t)(g.kst * 2);
    const size_t hstep = (size_t)HALF * K * 2;
    const size_t tstep = 2 * hstep;
    const unsigned ldsw = (unsigned)wid * 1024u;
    const int aoff = lds_byte(wr * 64 + fr, fq * 8), boff = lds_byte(wc * 32 + fr, fq * 8);
#define PG8_SA(b, h) (((b) * 2 + (h)) * HTB)
#define PG8_SB(b, h) ((4 + (b) * 2 + (h)) * HTB)
#define PG8_STAGE(bufoff, gbase, voff) do { _Pragma("unroll") for (int _i = 0; _i < 2; ++_i) \
        __builtin_amdgcn_global_load_lds((const unsigned*)((const char*)(gbase) + (voff)[_i]), (PG8_LAS unsigned*)(lds + (bufoff) + ldsw + _i * 8192), 16, 0, 0); } while (0)
#define PG8_LDA(dst, b, h) do { _Pragma("unroll") for (int m = 0; m < 4; ++m) _Pragma("unroll") for (int k = 0; k < 2; ++k) dst[m][k] = *(const PG8_LAS bf16x8*)(lds + PG8_SA(b, h) + aoff + m * 2048 + k * 1024); } while (0)
#define PG8_LDB(dst, b, h) do { _Pragma("unroll") for (int n = 0; n < 2; ++n) _Pragma("unroll") for (int k = 0; k < 2; ++k) dst[n][k] = *(const PG8_LAS bf16x8*)(lds + PG8_SB(b, h) + boff + n * 2048 + k * 1024); } while (0)
#define PG8_MMA(ai, bj, At, Bt) do { __builtin_amdgcn_s_setprio(1); _Pragma("unroll") for (int m = 0; m < 4; ++m) _Pragma("unroll") for (int n = 0; n < 2; ++n) _Pragma("unroll") for (int k = 0; k < 2; ++k) \
        acc[ai][bj][m][n] = __builtin_amdgcn_mfma_f32_16x16x32_bf16(Bt[n][k], At[m][k], acc[ai][bj][m][n], 0, 0, 0); __builtin_amdgcn_s_setprio(0); } while (0)
#define PG8_WAIT_V(n) asm volatile("s_waitcnt vmcnt(" #n ")" ::: "memory")
#define PG8_WAIT_L(n) asm volatile("s_waitcnt lgkmcnt(" #n ")" ::: "memory")
#define PG8_BAR __builtin_amdgcn_s_barrier()
#define PG8_SCHED __builtin_amdgcn_sched_barrier(0)
    Unit cur, nxt; int ui = 0;
    if (!S.next(0, cur)) return;
    f32x4 acc[2][2][4][2];
#pragma unroll
    for (int a = 0; a < 2; ++a)
#pragma unroll
        for (int b = 0; b < 2; ++b)
#pragma unroll
            for (int m = 0; m < 4; ++m)
#pragma unroll
                for (int n = 0; n < 2; ++n) acc[a][b][m][n] = (f32x4){0.f, 0.f, 0.f, 0.f};
    bf16x8 At[4][2], B0[2][2], B1[2][2];
    const char* cA = (const char*)g.A + (size_t)cur.pm * tstep; const char* cB = (const char*)g.Bt + (size_t)cur.pn * tstep;
    S.a_ready(cur);
    E.unit_begin(cur, wid, lane, 0);
    if constexpr (SP2) {
        PG8_STAGE(PG8_SB(0, 0), cB, voffB); PG8_STAGE(PG8_SB(0, 1), cB + hstep, voffB); PG8_STAGE(PG8_SA(0, 0), cA, voffA); PG8_STAGE(PG8_SA(0, 1), cA + hstep, voffA);
        if (wr == 1) PG8_BAR;
        PG8_WAIT_V(2); PG8_BAR;
        PG8_STAGE(PG8_SB(1, 0), cB + kstep, voffB); PG8_STAGE(PG8_SA(1, 0), cA + kstep, voffA); PG8_STAGE(PG8_SB(1, 1), cB + hstep + kstep, voffB);
        PG8_WAIT_V(6); PG8_BAR;
    } else {
        PG8_STAGE(PG8_SB(0, 0), cB, voffB); PG8_STAGE(PG8_SA(0, 0), cA, voffA); PG8_STAGE(PG8_SB(0, 1), cB + hstep, voffB); PG8_STAGE(PG8_SA(0, 1), cA + hstep, voffA);
        if (wr == 1) PG8_BAR;
        PG8_WAIT_V(4); PG8_BAR;
        PG8_STAGE(PG8_SB(1, 0), cB + kstep, voffB); PG8_STAGE(PG8_SA(1, 0), cA + kstep, voffA); PG8_STAGE(PG8_SB(1, 1), cB + hstep + kstep, voffB);
        PG8_WAIT_V(6); PG8_BAR;
    }
    for (;;) {
        const bool has_next = S.next(ui + 1, nxt);
        const char* nA = has_next ? (const char*)g.A + (size_t)nxt.pm * tstep : cA; const char* nB = has_next ? (const char*)g.Bt + (size_t)nxt.pn * tstep : cB;
        for (int t = 0; t < nt; t += 2) {
            const bool last = (t == nt - 2);
            const char* a1 = cA + (size_t)(t + 1) * kstep;
            const char* a2 = last ? nA : cA + (size_t)(t + 2) * kstep; const char* b2 = last ? nB : cB + (size_t)(t + 2) * kstep;
            const char* a3 = a2 + kstep; const char* b3 = b2 + kstep;
            if (last && has_next) S.a_ready(nxt);
            if constexpr (SP2) {
            PG8_LDB(B0, 0, 0); PG8_LDB(B1, 0, 1); PG8_SCHED; PG8_LDA(At, 0, 0); PG8_STAGE(PG8_SA(1, 1), a1 + hstep, voffA);
            PG8_WAIT_V(8); PG8_WAIT_L(0); PG8_BAR; PG8_MMA(0, 0, At, B0); PG8_MMA(0, 1, At, B1); PG8_BAR; PG8_SCHED;
            PG8_LDA(At, 0, 1); PG8_STAGE(PG8_SB(0, 0), b2, voffB); PG8_STAGE(PG8_SB(0, 1), b2 + hstep, voffB); PG8_STAGE(PG8_SA(0, 0), a2, voffA);
            PG8_WAIT_V(8); PG8_WAIT_L(0); PG8_BAR; PG8_MMA(1, 0, At, B0); PG8_MMA(1, 1, At, B1); PG8_BAR; PG8_SCHED;
            PG8_LDB(B0, 1, 0); PG8_LDB(B1, 1, 1); PG8_SCHED; PG8_LDA(At, 1, 0); PG8_STAGE(PG8_SA(0, 1), a2 + hstep, voffA);
            PG8_WAIT_V(8); PG8_WAIT_L(0); PG8_BAR; PG8_MMA(0, 0, At, B0); PG8_MMA(0, 1, At, B1); PG8_BAR; PG8_SCHED;
            PG8_LDA(At, 1, 1); PG8_STAGE(PG8_SB(1, 0), b3, voffB); PG8_STAGE(PG8_SB(1, 1), b3 + hstep, voffB); PG8_STAGE(PG8_SA(1, 0), a3, voffA);
            PG8_WAIT_V(8); PG8_WAIT_L(0); PG8_BAR; PG8_MMA(1, 0, At, B0); PG8_MMA(1, 1, At, B1); PG8_BAR; PG8_SCHED;
            } else {
            PG8_LDB(B0, 0, 0); PG8_SCHED; PG8_LDA(At, 0, 0); PG8_STAGE(PG8_SA(1, 1), a1 + hstep, voffA);
            PG8_WAIT_L(8); PG8_BAR; PG8_WAIT_L(0); PG8_MMA(0, 0, At, B0); PG8_BAR; PG8_SCHED;
            PG8_LDB(B1, 0, 1); PG8_STAGE(PG8_SB(0, 0), b2, voffB);
            PG8_BAR; PG8_WAIT_L(0); PG8_MMA(0, 1, At, B1); PG8_BAR;
            PG8_LDA(At, 0, 1); PG8_STAGE(PG8_SA(0, 0), a2, voffA);
            PG8_BAR; PG8_WAIT_L(0); PG8_MMA(1, 0, At, B0); PG8_BAR; PG8_SCHED;
            PG8_STAGE(PG8_SB(0, 1), b2 + hstep, voffB);
            PG8_WAIT_V(6); PG8_BAR; PG8_MMA(1, 1, At, B1); PG8_BAR;
            PG8_LDB(B0, 1, 0); PG8_SCHED; PG8_LDA(At, 1, 0); PG8_STAGE(PG8_SA(0, 1), a2 + hstep, voffA);
            PG8_WAIT_L(8); PG8_BAR; PG8_WAIT_L(0); PG8_MMA(0, 0, At, B0); PG8_BAR; PG8_SCHED;
            PG8_LDB(B1, 1, 1); PG8_STAGE(PG8_SB(1, 0), b3, voffB);
            PG8_BAR; PG8_WAIT_L(0); PG8_MMA(0, 1, At, B1); PG8_BAR;
            PG8_LDA(At, 1, 1); PG8_STAGE(PG8_SA(1, 0), a3, voffA);
            PG8_BAR; PG8_WAIT_L(0); PG8_MMA(1, 0, At, B0); PG8_BAR; PG8_SCHED;
            PG8_STAGE(PG8_SB(1, 1), b3 + hstep, voffB);
            PG8_WAIT_V(6); PG8_BAR; PG8_MMA(1, 1, At, B1); PG8_BAR;
            }
        }
        if constexpr (ALIGN_EPI) { if (wr == 0) PG8_BAR; }
        if constexpr (!Epi::AFTER_DRAIN) { E(acc, cur, wr, wc, fr, fq, ui & 1); S.done(cur); }
        if (!has_next) break;
#pragma unroll
        for (int a = 0; a < 2; ++a)
#pragma unroll
            for (int b = 0; b < 2; ++b)
#pragma unroll
                for (int m = 0; m < 4; ++m)
#pragma unroll
                    for (int n = 0; n < 2; ++n) acc[a][b][m][n] = (f32x4){0.f, 0.f, 0.f, 0.f};
        cur = nxt; cA = nA; cB = nB; ++ui;
        E.unit_begin(cur, wid, lane, ui & 1);
        if constexpr (ALIGN_EPI) { if (wr == 1) PG8_BAR; }
    }
    PG8_WAIT_V(0);
    if constexpr (!ALIGN_EPI) { if (wr == 0) PG8_BAR; }
    PG8_BAR;
    if constexpr (Epi::AFTER_DRAIN) { E.fused(acc, cur, wr, wc, fr, fq, lds, wid, lane); S.done(cur); }
#undef PG8_SA
#undef PG8_SB
#undef PG8_STAGE
#undef PG8_LDA
#undef PG8_LDB
#undef PG8_MMA
#undef PG8_WAIT_V
#undef PG8_WAIT_L
#undef PG8_BAR
#undef PG8_SCHED
}
}
constexpr int BATCH = 4, SEQ = 4096, DM = 2048, DEPTH = 4, M = BATCH * SEQ;
constexpr int MEMT = 256, MEMW = 512, MIXW = 1536, DFF = 5632, MEMROWS = BATCH * MEMT;
constexpr int RET_H = 6, RET_C = 128, RET_NC = SEQ / RET_C;
constexpr int MOBA_H = 12, MOBA_NB = SEQ / 256;
constexpr int NWAVES = 8, NTHREADS = 512;
constexpr int N_IN = 43;

constexpr size_t MiB = 1u << 20;
constexpr size_t WS_CTL = 0, CTL_ZERO_BYTES = 2 * MiB;
constexpr size_t WS_ROWSQ = 256 * 1024;
constexpr size_t WS_KMEAN = 1536 * 1024;
constexpr size_t WS_WMEMKV = 3 * MiB;
constexpr size_t WS_WL = 19 * MiB, WL_STRIDE = 100 * MiB;
constexpr size_t WL_IN = 0, WL_O = 26 * MiB, WL_UP = 34 * MiB, WL_DOWN = 78 * MiB;
constexpr size_t WS_XB = 419 * MiB;
constexpr size_t WS_MEMN = 483 * MiB;
constexpr size_t WS_MEMKV = 487 * MiB;
constexpr size_t WS_A = 495 * MiB;
constexpr size_t WS_PROJ = WS_A, WS_CAT = WS_A + 208 * MiB, WS_SBUF = WS_A + 272 * MiB;
constexpr size_t WS_ACT = WS_A + 192 * MiB;
constexpr size_t WS_HALO = WS_A + 368 * MiB;
constexpr size_t WS_CONVS = WS_A + 379 * MiB;
constexpr size_t WS_END = WS_A + 380 * MiB;
constexpr size_t WS_SCRX = WS_A, WS_SCRXB = WS_A + 128 * MiB, WS_SCRRSQ = WS_A + 379 * MiB, WS_END_PROBE = WS_END;
constexpr int CW_QUEUE = 64;
constexpr int CW_VER = 128;
constexpr int CW_LBAR = 8192;
constexpr int CW_BAR = 4096;

constexpr int LDS_BYTES = 163840;
constexpr int MISC_OFF = 163840 - 256;

#define GAS __attribute__((address_space(1)))
#define LAS __attribute__((address_space(3)))
typedef unsigned short bf16;
typedef float f32x4 __attribute__((ext_vector_type(4)));
typedef float f32x16 __attribute__((ext_vector_type(16)));
typedef short bf16x8 __attribute__((ext_vector_type(8)));
typedef short s16x4 __attribute__((ext_vector_type(4)));
typedef unsigned u32x4 __attribute__((ext_vector_type(4)));
typedef unsigned u32x2 __attribute__((ext_vector_type(2)));
typedef LAS unsigned char lds_t;
#define VM_WAIT() asm volatile("s_waitcnt vmcnt(0)" ::: "memory")
#define LDS_WAIT() asm volatile("s_waitcnt lgkmcnt(0)" ::: "memory")
#define SBAR() __builtin_amdgcn_sched_barrier(0)
#define WG_BAR() do { asm volatile("s_waitcnt lgkmcnt(0)" ::: "memory"); __builtin_amdgcn_s_barrier(); asm volatile("" ::: "memory"); } while (0)
__device__ __forceinline__ float bf2f(unsigned short b) { return __uint_as_float(((unsigned)b) << 16); }
__device__ __forceinline__ float bflo(unsigned w) { return __uint_as_float(w << 16); }
__device__ __forceinline__ float bfhi(unsigned w) { return __uint_as_float(w & 0xffff0000u); }
__device__ __forceinline__ unsigned pk2(float lo, float hi) { return pg8::cvt_pk_bf16(lo, hi); }
__device__ __forceinline__ float wave_sum(float v) {
#pragma unroll
    for (int o = 1; o < 64; o <<= 1) v += __shfl_xor(v, o);
    return v;
}
__device__ __forceinline__ int mk_tid(int wave_s) { int l; asm volatile("v_mbcnt_lo_u32_b32 %0, -1, 0\n\tv_mbcnt_hi_u32_b32 %0, -1, %0" : "=v"(l)); return wave_s * 64 + l; }
__device__ __forceinline__ float silu_f(float v) { return v * __builtin_amdgcn_rcpf(1.0f + __builtin_amdgcn_exp2f(-1.4426950408889634f * v)); }

#define XB_TMO      128
#define XB_XCNT(j)  (256  + 64 * (j))
#define XB_XSUB(j)  (1280 + 64 * (j))
#define XB_XGEN(j)  (2304 + 64 * (j))
#define XB_TOP      3328
#define XB_TOPGEN   3392
#define XCD_BAR_WORDS 3456
#define XB_SPIN_CAP (1u << 18)

__device__ __forceinline__ unsigned xb_ld(unsigned* p)              { return __hip_atomic_load(p, __ATOMIC_RELAXED, __HIP_MEMORY_SCOPE_AGENT); }
__device__ __forceinline__ unsigned xb_add(unsigned* p, unsigned v) { return __hip_atomic_fetch_add(p, v, __ATOMIC_RELAXED, __HIP_MEMORY_SCOPE_AGENT); }
__device__ __forceinline__ unsigned xb_xcc_id() { return (unsigned)__builtin_amdgcn_s_getreg((3 << 11) | 20) & 0xFu; }
#define XB_SPIN(cond, bar) do { unsigned _sp = 0; while (cond) { __builtin_amdgcn_s_sleep(1); \
    if ((++_sp & 255u) == 0u) { if (xb_ld(&(bar)[XB_TMO])) break; if (_sp > XB_SPIN_CAP) { atomicAdd(&(bar)[XB_TMO], 1u); break; } } } } while (0)

struct XcdBarrier {
    unsigned* bar; unsigned x;
    volatile LAS unsigned* st;
};

__device__ __forceinline__ XcdBarrier xcd_barrier_post(unsigned* bar, volatile LAS unsigned* st) {
    XcdBarrier b; b.bar = bar; b.x = xb_xcc_id(); b.st = st;
    if (threadIdx.x == 0) (void)xb_add(&bar[XB_XCNT(b.x)], 1u);
    return b;
}
__device__ __forceinline__ void xcd_barrier_complete(unsigned* bar, unsigned x, unsigned& nloc, unsigned& nx) {
    const unsigned G = gridDim.x * gridDim.y * gridDim.z;
    unsigned sum, cnt, mine, sp = 0u;
    for (;;) {
        sum = 0u; cnt = 0u; mine = 0u;
#pragma unroll
        for (unsigned j = 0; j < 16; ++j) { const unsigned c = xb_ld(&bar[XB_XCNT(j)]); sum += c; cnt += (c > 0u) ? 1u : 0u; mine = (j == x) ? c : mine; }
        if (sum == G) break;
        __builtin_amdgcn_s_sleep(1);
        if ((++sp & 255u) == 0u) { if (xb_ld(&bar[XB_TMO])) break; if (sp > XB_SPIN_CAP) { atomicAdd(&bar[XB_TMO], 1u); break; } }
    }
    nloc = mine > 0u ? mine : 1u; nx = cnt > 0u ? cnt : 1u;
}

__device__ __forceinline__ void xcd_barrier(const XcdBarrier& b) {
    asm volatile("s_waitcnt vmcnt(0)" ::: "memory");
    __syncthreads();
    if (threadIdx.x == 0) {
        unsigned* bar = b.bar;
        __builtin_amdgcn_s_waitcnt(0);
        unsigned nloc = b.st[0], nx = b.st[1];
        if (nloc == 0u) { xcd_barrier_complete(bar, b.x, nloc, nx); b.st[0] = nloc; b.st[1] = nx; }
        const unsigned old = xb_add(&bar[XB_XSUB(b.x)], 1u);
        const unsigned gen = old / nloc;
        if (old + 1u == (gen + 1u) * nloc) {
            __builtin_amdgcn_fence(__ATOMIC_RELEASE, "agent");
            asm volatile("s_waitcnt vmcnt(0)" ::: "memory");
            const unsigned og = xb_add(&bar[XB_TOP], 1u);
            const unsigned tg = og / nx;
            if (og + 1u == (tg + 1u) * nx) xb_add(&bar[XB_TOPGEN], 1u);
            else XB_SPIN(xb_ld(&bar[XB_TOPGEN]) == tg, bar);
            __builtin_amdgcn_fence(__ATOMIC_ACQUIRE, "agent");
            xb_add(&bar[XB_XGEN(b.x)], 1u);
            asm volatile("s_waitcnt vmcnt(0)" ::: "memory");
        } else {
            XB_SPIN(xb_ld(&bar[XB_XGEN(b.x)]) == gen, bar);
            __builtin_amdgcn_fence(__ATOMIC_ACQUIRE, "agent");
            asm volatile("s_waitcnt vmcnt(0)" ::: "memory");
        }
    }
    __syncthreads();
}


__device__ __forceinline__ void xcd_local_barrier(const XcdBarrier& b, unsigned* lb) {
    asm volatile("s_waitcnt vmcnt(0)" ::: "memory");
    __syncthreads();
    if (threadIdx.x == 0) {
        __builtin_amdgcn_s_waitcnt(0);
        const unsigned nloc = b.st[0];
        const unsigned old = xb_add(&lb[64 * b.x], 1u), gen = old / nloc;
        if (old + 1u == (gen + 1u) * nloc) xb_add(&lb[1024 + 64 * b.x], 1u);
        else XB_SPIN(xb_ld(&lb[1024 + 64 * b.x]) == gen, b.bar);
        __builtin_amdgcn_fence(__ATOMIC_ACQUIRE, "agent");
        asm volatile("s_waitcnt vmcnt(0)" ::: "memory");
    }
    __syncthreads();
}

template <bool GU>
__device__ __forceinline__ void transpose_item(const float* W, int K, int N, bf16* WT, const float* gain, LAS float* scr, int item, int lane) {
    const int nkb2 = K / 128, w8 = item & 7, I = item >> 3, kb = 2 * (I % nkb2) + (w8 & 1), nb = 4 * (I / nkb2) + (w8 >> 1), k0 = 64 * kb, n0 = 64 * nb;
    const int d0 = GU ? (((n0 % DFF) >> 7) * 256 + (n0 >= DFF ? 128 : 0) + (n0 & 127)) : n0;
    const int lr = lane >> 4, lc = (lane & 15) * 4;
    f32x4 v[16];
#pragma unroll
    for (int j = 0; j < 16; ++j) v[j] = __builtin_nontemporal_load((const f32x4*)(W + (size_t)(k0 + lr + 4 * j) * N + n0 + lc));
#pragma unroll
    for (int j = 0; j < 16; ++j) *(LAS f32x4*)(scr + (lr + 4 * j) * 68 + lc) = v[j];
    LDS_WAIT(); asm volatile("" ::: "memory");
    const int c = lane & 7;
    f32x4 g0 = (f32x4){1.f, 1.f, 1.f, 1.f}, g1 = g0;
    if (gain) { g0 = *(const f32x4*)(gain + k0 + 8 * c); g1 = *(const f32x4*)(gain + k0 + 8 * c + 4); }
#pragma unroll
    for (int j = 0; j < 8; ++j) { const int n = (lane >> 3) + 8 * j; const LAS float* s = scr + (8 * c) * 68 + n;
        u32x4 o; o.x = pk2(s[0 * 68] * g0[0], s[1 * 68] * g0[1]); o.y = pk2(s[2 * 68] * g0[2], s[3 * 68] * g0[3]); o.z = pk2(s[4 * 68] * g1[0], s[5 * 68] * g1[1]); o.w = pk2(s[6 * 68] * g1[2], s[7 * 68] * g1[3]);
        *(u32x4*)(WT + (size_t)(d0 + n) * K + k0 + 8 * c) = o; }
    LDS_WAIT(); asm volatile("" ::: "memory");
}
template <bool GU = false>
__device__ __forceinline__ void convert_matrix(const float* W, int K, int N, bf16* WT, const float* gain, lds_t* lds, int gw, int ngw, int wave, int lane) {
    LAS float* scr = (LAS float*)(lds + wave * 17408);
    const int nitems = (K / 64) * (N / 64);
    for (int it = gw; it < nitems; it += ngw) transpose_item<GU>(W, K, N, WT, gain, scr, it, lane);
}
__device__ __forceinline__ void x_row_prologue(const float* xrow, bf16* orow, pg8::rsq_t* rowsq, int lane) {
    const f32x4* xr = (const f32x4*)xrow + lane; f32x4 v[8]; float s = 0.f;
#pragma unroll
    for (int j = 0; j < 8; ++j) { v[j] = __builtin_nontemporal_load(xr + 64 * j); s += (v[j].x * v[j].x + v[j].y * v[j].y) + (v[j].z * v[j].z + v[j].w * v[j].w); }
    s = wave_sum(s);
    u32x2* o8 = (u32x2*)orow + lane;
#pragma unroll
    for (int j = 0; j < 8; ++j) { u32x2 w; w.x = pk2(v[j].x, v[j].y); w.y = pk2(v[j].z, v[j].w); o8[64 * j] = w; }
    if (lane == 0) *rowsq = (pg8::rsq_t)(s * pg8::RSQ_FIX);
}
__device__ __forceinline__ void norm_row_bf16(const float* xrow, const float* gain, bf16* orow, int lane) {
    const f32x4* xr = (const f32x4*)xrow + lane; const f32x4* gr = (const f32x4*)gain + lane; f32x4 v[8]; float s = 0.f;
#pragma unroll
    for (int j = 0; j < 8; ++j) { v[j] = xr[64 * j]; s += (v[j].x * v[j].x + v[j].y * v[j].y) + (v[j].z * v[j].z + v[j].w * v[j].w); }
    const float rs = __builtin_amdgcn_rsqf(wave_sum(s) * (1.f / DM) + pg8::RMS_EPS);
    u32x2* o8 = (u32x2*)orow + lane;
#pragma unroll
    for (int j = 0; j < 8; ++j) { const f32x4 g = gr[64 * j]; u32x2 w; w.x = pk2(v[j].x * rs * g.x, v[j].y * rs * g.y); w.y = pk2(v[j].z * rs * g.z, v[j].w * rs * g.w); o8[64 * j] = w; }
}

namespace att {
__device__ __forceinline__ int crow(int r, int hi) { return (r & 3) + 8 * (r >> 2) + 4 * hi; }
#define KSWZ(RB, row, colB) ((row) * (RB) + ((colB) ^ (((row) & 7) << 4)))
__device__ __forceinline__ int v_st(int k, int c) { const int kk = (k & ~0xC) | ((k & 4) << 1) | ((k & 8) >> 1); return ((kk >> 3) * 4 + (c >> 5)) * 512 + ((kk & 7) * 32 + (c & 31)) * 2; }
__device__ __forceinline__ int v_rd_base(int lane) { return ((lane & 3) << 3) | (((lane >> 2) & 3) << 6) | (((lane >> 4) & 1) << 5) | (((lane >> 5) & 1) << 8); }
constexpr int v_rd_off(int d0, int ks, int half) { return d0 * 512 + ks * 4096 + half * 2048; }
template <int OFF> __device__ __forceinline__ s16x4 tr_read(int vb) {
    s16x4 r; asm volatile("ds_read_b64_tr_b16 %0, %1 offset:%2" : "=&v"(r) : "v"(vb), "i"(OFF) : "memory"); return r;
}
template <int D0> __device__ __forceinline__ void pv_one(f32x16& od, int vb, bf16x8 pa0, bf16x8 pa1, bf16x8 pa2, bf16x8 pa3) {
    const s16x4 l0 = tr_read<v_rd_off(D0, 0, 0)>(vb), h0 = tr_read<v_rd_off(D0, 0, 1)>(vb), l1 = tr_read<v_rd_off(D0, 1, 0)>(vb), h1 = tr_read<v_rd_off(D0, 1, 1)>(vb);
    const s16x4 l2 = tr_read<v_rd_off(D0, 2, 0)>(vb), h2 = tr_read<v_rd_off(D0, 2, 1)>(vb), l3 = tr_read<v_rd_off(D0, 3, 0)>(vb), h3 = tr_read<v_rd_off(D0, 3, 1)>(vb);
    asm volatile("s_waitcnt lgkmcnt(0)" ::: "memory"); SBAR();
#define PK(L, H) (bf16x8){L[0], L[1], L[2], L[3], H[0], H[1], H[2], H[3]}
    od = __builtin_amdgcn_mfma_f32_32x32x16_bf16(pa0, PK(l0, h0), od, 0, 0, 0);
    od = __builtin_amdgcn_mfma_f32_32x32x16_bf16(pa1, PK(l1, h1), od, 0, 0, 0);
    od = __builtin_amdgcn_mfma_f32_32x32x16_bf16(pa2, PK(l2, h2), od, 0, 0, 0);
    od = __builtin_amdgcn_mfma_f32_32x32x16_bf16(pa3, PK(l3, h3), od, 0, 0, 0);
#undef PK
}
__device__ __forceinline__ void pv_d0(f32x16* o, int vb, bf16x8 pa0, bf16x8 pa1, bf16x8 pa2, bf16x8 pa3) {
    pv_one<0>(o[0], vb, pa0, pa1, pa2, pa3); pv_one<1>(o[1], vb, pa0, pa1, pa2, pa3); pv_one<2>(o[2], vb, pa0, pa1, pa2, pa3); pv_one<3>(o[3], vb, pa0, pa1, pa2, pa3);
}
template <int ND0> __device__ __forceinline__ void qkt(f32x16& p0, f32x16& p1, const lds_t* Ks, const bf16x8* qr, int r32, int hi) {
    constexpr int RB = ND0 * 32;
    p0 = f32x16{}; p1 = f32x16{};
#pragma unroll
    for (int d0 = 0; d0 < ND0; ++d0) { const int cb = (d0 * 16 + hi * 8) * 2;
        const bf16x8 b0 = *(const LAS bf16x8*)(Ks + KSWZ(RB, r32, cb));
        const bf16x8 b1 = *(const LAS bf16x8*)(Ks + KSWZ(RB, 32 + r32, cb));
        p0 = __builtin_amdgcn_mfma_f32_32x32x16_bf16(b0, qr[d0], p0, 0, 0, 0);
        p1 = __builtin_amdgcn_mfma_f32_32x32x16_bf16(b1, qr[d0], p1, 0, 0, 0); }
}
__device__ __forceinline__ void pack_p(const f32x16& p0, const f32x16& p1, bf16x8& pa0, bf16x8& pa1, bf16x8& pa2, bf16x8& pa3) {
#define PK4(P, BASE, OUT) do { unsigned a0 = pk2(P[BASE + 0], P[BASE + 1]), a1 = pk2(P[BASE + 2], P[BASE + 3]);   \
    unsigned b0 = pk2(P[BASE + 4], P[BASE + 5]), b1 = pk2(P[BASE + 6], P[BASE + 7]);                              \
    auto r0 = __builtin_amdgcn_permlane32_swap(a0, b0, false, false); auto r1 = __builtin_amdgcn_permlane32_swap(a1, b1, false, false); \
    u32x4 w = {r0[0], r1[0], r0[1], r1[1]}; OUT = __builtin_bit_cast(bf16x8, w); } while (0)
    PK4(p0, 0, pa0); PK4(p0, 8, pa1); PK4(p1, 0, pa2); PK4(p1, 8, pa3);
#undef PK4
}

constexpr int OST_PITCH = 272, OST_BYTES = 32 * OST_PITCH;
__device__ __forceinline__ void stage_o_tile(lds_t* st, const f32x16* o, const float* rsc, const float* csc, int r32, int hi) {
#pragma unroll
    for (int r = 0; r < 16; ++r) { lds_t* rp = st + crow(r, hi) * OST_PITCH + r32 * 2;
#pragma unroll
        for (int d0 = 0; d0 < 4; ++d0) *(LAS unsigned short*)(rp + d0 * 64) = (unsigned short)(pk2(o[d0][r] * rsc[r] * csc[d0], 0.f) & 0xffffu); }
    LDS_WAIT();
}
template <bool MOBA>
__device__ __forceinline__ void attn_unit(int wave_s, const bf16* Qb, int ldq, const bf16* Kb, const bf16* Vb, int ldk, bf16* Ob, int ldo, int NT, int own, float slope2, const float* kmean_g, lds_t* lds) {
    int tid_ = mk_tid(wave_s);
    const int tid = tid_, wid = tid >> 6, lane = tid & 63, r32 = lane & 31, hi = lane >> 5;
    lds_t* V_lds = lds; lds_t* K_lds = lds + 49152;
    LAS float* wsf = (LAS float*)(lds + 98304) + wid * 64; LAS float* li_l = wsf; LAS float* al_l = wsf + 32;
    LAS float* km_l = (LAS float*)(lds + 98304 + 2048);
    constexpr float C = 0.088388347648318440f * 1.4426950408889634f;
    constexpr float THR2 = 8.0f;
    const float NEG_INF = -__builtin_inff(), POS_INF = __builtin_inff();
    bf16x8 qr[8];
    { const bf16* Qw = Qb + (size_t)(wid * 32 + r32) * ldq + hi * 8;
#pragma unroll
      for (int d0 = 0; d0 < 8; ++d0) qr[d0] = *(const bf16x8*)(Qw + d0 * 16); }
    unsigned selmask = 0xffffffffu; int qrel = 0;
    if constexpr (MOBA) {
        for (int i = tid; i < 2048; i += NTHREADS) km_l[i] = kmean_g[i];
        __syncthreads();
        float g[16];
#pragma unroll
        for (int j = 0; j < 16; ++j) g[j] = 0.f;
        const bf16* Qg = Qb + (size_t)(wid * 32 + r32) * ldq + hi * 8;
#pragma unroll 1
        for (int d0 = 0; d0 < 8; ++d0) { const u32x4 qw = *(const u32x4*)(Qg + d0 * 16);
            const float q0 = bflo(qw.x), q1 = bfhi(qw.x), q2 = bflo(qw.y), q3 = bfhi(qw.y), q4 = bflo(qw.z), q5 = bfhi(qw.z), q6 = bflo(qw.w), q7 = bfhi(qw.w);
#pragma unroll
            for (int j = 0; j < 16; ++j) { const f32x4 a = *(const LAS f32x4*)(km_l + j * 128 + d0 * 16 + hi * 8), b = *(const LAS f32x4*)(km_l + j * 128 + d0 * 16 + hi * 8 + 4);
                g[j] += (q0 * a.x + q1 * a.y) + (q2 * a.z + q3 * a.w) + (q4 * b.x + q5 * b.y) + (q6 * b.z + q7 * b.w); } }
#pragma unroll
        for (int j = 0; j < 16; ++j) g[j] += __shfl_xor(g[j], 32);
        selmask = 0u;
#pragma unroll
        for (int t = 0; t < 3; ++t) { float best = NEG_INF; int bi = -1;
#pragma unroll
            for (int j = 0; j < 16; ++j) { const bool ok = (j < own) && !((selmask >> j) & 1u) && (g[j] > best); best = ok ? g[j] : best; bi = ok ? j : bi; }
            if (bi >= 0) selmask |= 1u << bi; }
        selmask |= 1u << own;
        qrel = wid * 32 + r32;
    }
    const int vb0 = (int)(unsigned)(size_t)V_lds + v_rd_base(lane);
    const int wu = __builtin_amdgcn_readfirstlane(wid);
    unsigned koff[2], voff[2];
#pragma unroll
    for (int i = 0; i < 2; ++i) { const int pc = i * 8 + wid; const int row = pc * 4 + (lane >> 4), chunk = (lane & 15) ^ (row & 7); koff[i] = (unsigned)(row * ldk + chunk * 8);
        const int st = pc * 2 + (lane >> 5), kk = (st >> 2) * 8 + ((lane & 31) >> 2), k = (kk & ~0xC) | ((kk & 4) << 1) | ((kk & 8) >> 1), c = (st & 3) * 32 + (lane & 3) * 8; voff[i] = (unsigned)(k * ldk + c); }
    const float s32 = MOBA ? slope2 * 32.f : 0.f, sh4 = MOBA ? slope2 * (float)(4 * hi) : 0.f;
#define tk(j) (MOBA ? ((j) < 4 ? own * 256 + 64 * (j) : (own - 1 - (((j) - 4) >> 2)) * 256 + 64 * (((j) - 4) & 3)) : 64 * (j))
#define SDMA(k0, b) do { const bf16* kt_ = Kb + (size_t)(k0) * ldk; const bf16* vt_ = Vb + (size_t)(k0) * ldk; _Pragma("unroll") for (int i_ = 0; i_ < 2; ++i_) { \
    __builtin_amdgcn_global_load_lds((const unsigned*)(kt_ + koff[i_]), (LAS unsigned*)(K_lds + (b) * 16384 + (i_ * 8 + wu) * 1024), 16, 0, 0); \
    __builtin_amdgcn_global_load_lds((const unsigned*)(vt_ + voff[i_]), (LAS unsigned*)(V_lds + (b) * 16384 + (i_ * 8 + wu) * 1024), 16, 0, 0); } } while (0)
    float m_reg = -1e30f, l_reg = 0.f; f32x16 o[4] = {};
    SDMA(tk(0), 0); if (NT > 1) { SDMA(tk(1), 1); asm volatile("s_waitcnt vmcnt(4)" ::: "memory"); } else VM_WAIT();
    WG_BAR();
    int cur = 0, nx1 = 1, nx2 = 2;
    for (int j = 0; j < NT; ++j) {
        if (j + 2 < NT) SDMA(tk(j + 2), nx2);
        bool active = true, partial = false, rv = true; float base = 0.f;
        if constexpr (MOBA) {
            const int k0 = tk(j), blk = k0 >> 8, krel = k0 - own * 256;
            rv = (selmask >> blk) & 1u; base = slope2 * (float)krel;
            if (blk == own) { active = krel <= wu * 32 + 31; partial = krel + 63 > wu * 32; }
            else active = __any(rv);
        }
        if (active) {
            f32x16 p0, p1;
            qkt<8>(p0, p1, K_lds + cur * 16384, qr, r32, hi);
#pragma unroll
            for (int r = 0; r < 16; ++r) { const float scr = MOBA ? fmaf(slope2, (float)((r & 3) + 8 * (r >> 2)), sh4) : 0.f; p0[r] = fmaf(p0[r], C, scr); p1[r] = fmaf(p1[r], C, scr); }
            if constexpr (MOBA) { if (partial) { const int lim = qrel - (tk(j) - own * 256);
#pragma unroll
                for (int r = 0; r < 16; ++r) { const int ko = crow(r, hi); p0[r] = (ko <= lim) ? p0[r] : NEG_INF; p1[r] = (ko + 32 <= lim) ? p1[r] : NEG_INF; } } }
            float mx0 = p0[0], mx1 = p1[0];
#pragma unroll
            for (int r = 1; r < 16; ++r) { mx0 = fmaxf(mx0, p0[r]); mx1 = fmaxf(mx1, p1[r]); }
            float pmax = fmaxf(mx0, mx1 + s32) + base; pmax = rv ? pmax : NEG_INF;
            { auto rr = __builtin_amdgcn_permlane32_swap(__float_as_uint(pmax), __float_as_uint(pmax), false, false); pmax = fmaxf(__uint_as_float(rr[0]), __uint_as_float(rr[1])); }
            float alpha = 1.f;
            if (!__all(pmax - m_reg <= THR2)) {
                const float mn = fmaxf(m_reg, pmax); alpha = __builtin_amdgcn_exp2f(m_reg - mn); m_reg = mn;
                if (hi == 0) al_l[r32] = alpha; LDS_WAIT();
#pragma unroll
                for (int r = 0; r < 16; ++r) { const float a = al_l[crow(r, hi)];
#pragma unroll
                    for (int d = 0; d < 4; ++d) o[d][r] *= a; }
            }
            const float ms0 = rv ? (m_reg - base) : POS_INF, ms1 = ms0 - s32;
            float ps = 0.f;
#pragma unroll
            for (int r = 0; r < 16; ++r) { p0[r] = __builtin_amdgcn_exp2f(p0[r] - ms0); p1[r] = __builtin_amdgcn_exp2f(p1[r] - ms1); ps += p0[r] + p1[r]; }
            { auto rr = __builtin_amdgcn_permlane32_swap(__float_as_uint(ps), __float_as_uint(ps), false, false); ps = __uint_as_float(rr[0]) + __uint_as_float(rr[1]); }
            l_reg = l_reg * alpha + ps;
            bf16x8 pa0, pa1, pa2, pa3; pack_p(p0, p1, pa0, pa1, pa2, pa3);
            pv_d0(o, vb0 + cur * 16384, pa0, pa1, pa2, pa3);
        }
        if (j + 2 < NT) asm volatile("s_waitcnt vmcnt(4)" ::: "memory"); else VM_WAIT();
        WG_BAR();
        { const int t = cur; cur = nx1; nx1 = nx2; nx2 = t; }
    }
#undef SDMA
#undef tk
    if (hi == 0) li_l[r32] = l_reg; LDS_WAIT();
    { int hi_e = hi, r32_e = r32, wid_e = wid, lane_e = lane; asm volatile("" : "+v"(hi_e), "+v"(r32_e), "+v"(wid_e), "+v"(lane_e));
      LAS float* li_e = (LAS float*)(lds + 98304) + wid_e * 64; float rsc[16]; const float one[4] = {1.f, 1.f, 1.f, 1.f};
#pragma unroll
      for (int r = 0; r < 16; ++r) rsc[r] = __builtin_amdgcn_rcpf(li_e[crow(r, hi_e)]);
      lds_t* stg = lds + wid_e * OST_BYTES;
      stage_o_tile(stg, o, rsc, one, r32_e, hi_e);
      bf16* Ow = Ob + (size_t)(wid_e * 32) * ldo;
#pragma unroll
      for (int j = 0; j < 8; ++j) { const int idx = j * 64 + lane_e, row = idx >> 4, ch = idx & 15;
          *(u32x4*)(Ow + (size_t)row * ldo + ch * 8) = *(const LAS u32x4*)(stg + row * OST_PITCH + ch * 16); } }
    __syncthreads();
}

__device__ __forceinline__ void ret_unit(int wave_s, const bf16* proj, int ldp, const bf16* Sb, const float* gn, bf16* cat, int b, int h, int n, float lg2g, lds_t* lds) {
    int tid_ = mk_tid(wave_s);
    const int tid = tid_, wid = tid >> 6, lane = tid & 63, r32 = lane & 31, hi = lane >> 5, wr = wid & 3, wc = wid >> 2;
    LAS float* T = (LAS float*)(lds + 131072);
    const size_t R0 = (size_t)b * SEQ + (size_t)n * RET_C;
    bf16x8 qr[16];
    { const bf16* Qw = proj + (R0 + wr * 32 + r32) * ldp + h * 256 + hi * 8;
#pragma unroll
      for (int d0 = 0; d0 < 16; ++d0) qr[d0] = *(const bf16x8*)(Qw + d0 * 16); }
    const int vbl = (int)(unsigned)(size_t)lds + wc * 16384 + v_rd_base(lane);
    const int wu = __builtin_amdgcn_readfirstlane(wid);
    unsigned koff[4], voff[4], soff[4];
#pragma unroll
    for (int i = 0; i < 4; ++i) { const int pc = i * 8 + wid; const int row = pc * 2 + (lane >> 5), chunk = (lane & 31) ^ (row & 7); koff[i] = (unsigned)(row * ldp + chunk * 8);
        const int img = pc >> 4, st = (pc & 15) * 2 + (lane >> 5), kk = (st >> 2) * 8 + ((lane & 31) >> 2), k = (kk & ~0xC) | ((kk & 4) << 1) | ((kk & 8) >> 1), c = img * 128 + (st & 3) * 32 + (lane & 3) * 8;
        voff[i] = (unsigned)(k * ldp + c); soff[i] = (unsigned)(k * 256 + c); }
    const bf16* Kg = proj + R0 * ldp + MIXW + h * 256; const bf16* Vg = proj + R0 * ldp + 2 * MIXW + h * 256;
#define RET_JOB_S(t) do { _Pragma("unroll") for (int i_ = 0; i_ < 4; ++i_) __builtin_amdgcn_global_load_lds((const unsigned*)(Sb + (size_t)(64 * (t)) * 256 + soff[i_]), (LAS unsigned*)(lds + (t) * 32768 + (i_ * 8 + wu) * 1024), 16, 0, 0); } while (0)
#define RET_JOB_K(kt, buf) do { _Pragma("unroll") for (int i_ = 0; i_ < 4; ++i_) __builtin_amdgcn_global_load_lds((const unsigned*)(Kg + (size_t)(64 * (kt)) * ldp + koff[i_]), (LAS unsigned*)(lds + (buf) * 32768 + (i_ * 8 + wu) * 1024), 16, 0, 0); } while (0)
#define RET_JOB_V(kt, buf) do { _Pragma("unroll") for (int i_ = 0; i_ < 4; ++i_) __builtin_amdgcn_global_load_lds((const unsigned*)(Vg + (size_t)(64 * (kt)) * ldp + voff[i_]), (LAS unsigned*)(lds + (buf) * 32768 + (i_ * 8 + wu) * 1024), 16, 0, 0); } while (0)
#define RET_WAIT(nleft) do { asm volatile("s_waitcnt vmcnt(" #nleft ")" ::: "memory"); WG_BAR(); } while (0)
#define RET_KV(kt, kbuf, vbuf) do { if (64 * (kt) <= 32 * wr + 31) { f32x16 p0, p1; qkt<16>(p0, p1, lds + (kbuf) * 32768, qr, r32, hi); const int c = wr * 32 + r32; \
        _Pragma("unroll") for (int r = 0; r < 16; ++r) { const int m0 = 64 * (kt) + crow(r, hi); p0[r] = (c >= m0) ? p0[r] : 0.f; p1[r] = (c >= m0 + 32) ? p1[r] : 0.f; } \
        bf16x8 pa0, pa1, pa2, pa3; pack_p(p0, p1, pa0, pa1, pa2, pa3); pv_d0(o, vbl + (vbuf) * 32768, pa0, pa1, pa2, pa3); } } while (0)
    f32x16 o[4] = {};
    if (n > 0) {
        RET_JOB_S(0); RET_JOB_S(1); RET_JOB_S(2); RET_JOB_S(3);
        RET_WAIT(12);                 pv_d0(o, vbl + 0 * 32768, qr[0], qr[1], qr[2], qr[3]);
        RET_WAIT(8);  RET_JOB_K(0, 0); pv_d0(o, vbl + 1 * 32768, qr[4], qr[5], qr[6], qr[7]);
        RET_WAIT(8);  RET_JOB_V(0, 1); pv_d0(o, vbl + 2 * 32768, qr[8], qr[9], qr[10], qr[11]);
        RET_WAIT(8);  RET_JOB_K(1, 2); pv_d0(o, vbl + 3 * 32768, qr[12], qr[13], qr[14], qr[15]);
        { const float g128 = __builtin_amdgcn_exp2f(128.f * lg2g);
#pragma unroll
          for (int d = 0; d < 4; ++d)
#pragma unroll
              for (int r = 0; r < 16; ++r) o[d][r] *= g128; }
        RET_WAIT(4);  RET_JOB_V(1, 3); RET_KV(0, 0, 1);
        RET_WAIT(0);                  RET_KV(1, 2, 3);
    } else {
        RET_JOB_K(0, 0); RET_JOB_V(0, 1); RET_JOB_K(1, 2); RET_JOB_V(1, 3);
        RET_WAIT(8); RET_KV(0, 0, 1);
        RET_WAIT(0); RET_KV(1, 2, 3);
    }
#undef RET_JOB_S
#undef RET_JOB_K
#undef RET_JOB_V
#undef RET_WAIT
#undef RET_KV
    int hi_e = hi, r32_e = r32, wr_e = wr, wc_e = wc, wid_e = wid, lane_e = lane; asm volatile("" : "+v"(hi_e), "+v"(r32_e), "+v"(wr_e), "+v"(wc_e), "+v"(wid_e), "+v"(lane_e));
    float rsc[16];
#pragma unroll
    for (int r = 0; r < 16; ++r) { const float f = __builtin_amdgcn_exp2f(lg2g * (float)(wr_e * 32 + crow(r, hi_e) - 127)); float s = 0.f;
#pragma unroll
        for (int d = 0; d < 4; ++d) { o[d][r] *= f; s += o[d][r] * o[d][r]; }
        s += __shfl_xor(s, 1); s += __shfl_xor(s, 2); s += __shfl_xor(s, 4); s += __shfl_xor(s, 8); s += __shfl_xor(s, 16); rsc[r] = s; }
    if (r32_e == 0) {
#pragma unroll
        for (int r = 0; r < 16; ++r) T[wc_e * 128 + wr_e * 32 + crow(r, hi_e)] = rsc[r]; }
    __syncthreads();
    float gnv[4];
    const int colb = h * 256 + wc_e * 128;
#pragma unroll
    for (int d = 0; d < 4; ++d) gnv[d] = gn[colb + d * 32 + r32_e];
#pragma unroll
    for (int r = 0; r < 16; ++r) { const int rl = wr_e * 32 + crow(r, hi_e); rsc[r] = __builtin_amdgcn_rsqf((T[rl] + T[128 + rl]) * (1.f / 256.f) + pg8::RMS_EPS); }
    lds_t* stg = lds + wid_e * OST_BYTES;
    stage_o_tile(stg, o, rsc, gnv, r32_e, hi_e);
#pragma unroll
    for (int j = 0; j < 8; ++j) { const int idx = j * 64 + lane_e, row = idx >> 4, ch = idx & 15;
        const u32x4 yv = *(const LAS u32x4*)(stg + row * OST_PITCH + ch * 16);
        const size_t grow = R0 + wr_e * 32 + row;
        const u32x4 gv = *(const u32x4*)(proj + grow * ldp + 3 * MIXW + colb + ch * 8);
        u32x4 ov;
#pragma unroll
        for (int q = 0; q < 4; ++q) ov[q] = pk2(bflo(yv[q]) * silu_f(bflo(gv[q])), bfhi(yv[q]) * silu_f(bfhi(gv[q])));
        *(u32x4*)(cat + grow * DM + colb + ch * 8) = ov; }
    __syncthreads();
}

__device__ __forceinline__ s16x4 tr_read_v(int addr) { s16x4 r; asm volatile("ds_read_b64_tr_b16 %0, %1" : "=&v"(r) : "v"(addr) : "memory"); return r; }
__device__ __forceinline__ void scan_item(int wave_s, const bf16* proj, int ldp, bf16* Sbuf, int b, int h, int es, float lg2g, lds_t* lds) {
    int tid_ = mk_tid(wave_s);
    const int tid = tid_, wid = tid >> 6, lane = tid & 63, r32 = lane & 31, hi = lane >> 5;
    const int li = lane & 15, gp = (lane >> 4) & 1, wu = __builtin_amdgcn_readfirstlane(wid);
    const int lbase = (int)(unsigned)(size_t)lds;
    const int kb = lbase + (8 * hi + (li >> 2)) * 512 + (((4 * wid + 2 * gp + ((li & 3) >> 1)) ^ (((li >> 2) & 3) << 2)) * 16) + (li & 1) * 8;
    const int vb = lbase + 131072 + (8 * hi + (li >> 2)) * 64 + (16 * gp + 4 * (li & 3)) * 2;
    unsigned koff[4];
#pragma unroll
    for (int i = 0; i < 4; ++i) { const int pc = i * 8 + wid, row = 2 * pc + (lane >> 5), gch = (lane & 31) ^ ((row & 3) << 2); koff[i] = (unsigned)(row * ldp + gch * 8); }
    const unsigned voff = (unsigned)((16 * (wid & 3) + (lane >> 2)) * ldp + (lane & 3) * 8);
    const bf16* Kg = proj + ((size_t)b * SEQ) * ldp + MIXW + h * 256; const bf16* Vg = proj + ((size_t)b * SEQ) * ldp + 2 * MIXW + h * 256 + 32 * es;
    const float g128 = __builtin_amdgcn_exp2f(128.f * lg2g);
    bf16* Sp0 = Sbuf + ((size_t)((b * RET_H + h) * RET_NC) * 256) * 256 + (size_t)(32 * wid) * 256 + 32 * es + r32;
    f32x16 acc = {};
#define SCAN_DMA(s) do { const size_t t0_ = (size_t)(64 * (s)) * ldp; const int sl_ = (s) & 3; _Pragma("unroll") for (int i_ = 0; i_ < 4; ++i_) \
        __builtin_amdgcn_global_load_lds((const unsigned*)(Kg + t0_ + koff[i_]), (LAS unsigned*)(lds + sl_ * 32768 + (i_ * 8 + wu) * 1024), 16, 0, 0); \
    __builtin_amdgcn_global_load_lds((const unsigned*)(Vg + t0_ + voff), (LAS unsigned*)(lds + 131072 + sl_ * 4096 + (wu & 3) * 1024), 16, 0, 0); } while (0)
#define SCAN_MMA(sl) do { s16x4 a0_[4], a1_[4], b0_[4], b1_[4]; _Pragma("unroll") for (int ks = 0; ks < 4; ++ks) { \
        a0_[ks] = tr_read_v(kb + (sl) * 32768 + (16 * ks) * 512); a1_[ks] = tr_read_v(kb + (sl) * 32768 + (16 * ks + 4) * 512); \
        b0_[ks] = tr_read_v(vb + (sl) * 4096 + (16 * ks) * 64); b1_[ks] = tr_read_v(vb + (sl) * 4096 + (16 * ks + 4) * 64); } \
        LDS_WAIT(); SBAR();                                          \
        _Pragma("unroll") for (int ks = 0; ks < 4; ++ks) { \
        const bf16x8 A = (bf16x8){a0_[ks][0], a0_[ks][1], a0_[ks][2], a0_[ks][3], a1_[ks][0], a1_[ks][1], a1_[ks][2], a1_[ks][3]}, B = (bf16x8){b0_[ks][0], b0_[ks][1], b0_[ks][2], b0_[ks][3], b1_[ks][0], b1_[ks][1], b1_[ks][2], b1_[ks][3]}; \
        acc = __builtin_amdgcn_mfma_f32_32x32x16_bf16(A, B, acc, 0, 0, 0); } } while (0)
#define SCAN_STORE(n) do { bf16* Sp = Sp0 + (size_t)(n) * 65536; _Pragma("unroll") for (int r = 0; r < 16; ++r) Sp[(size_t)crow(r, hi) * 256] = (bf16)(pk2(acc[r], 0.f) & 0xffffu); } while (0)
    constexpr int NHS = 2 * (RET_NC - 1);
    SCAN_DMA(0); SCAN_DMA(1); SCAN_DMA(2);
#pragma unroll 1
    for (int n = 0; n < RET_NC - 1; ++n) {
        const int s0 = 2 * n;
        if (n == 0) asm volatile("s_waitcnt vmcnt(10)" ::: "memory"); else if (s0 + 2 < NHS) asm volatile("s_waitcnt vmcnt(26)" ::: "memory"); else asm volatile("s_waitcnt vmcnt(21)" ::: "memory");
        WG_BAR();
        if (s0 + 3 < NHS) SCAN_DMA(s0 + 3);
        SCAN_STORE(n);
#pragma unroll
        for (int r = 0; r < 16; ++r) acc[r] *= g128;
        if ((n & 1) == 0) SCAN_MMA(0); else SCAN_MMA(2);
        if (n == 0) asm volatile("s_waitcnt vmcnt(26)" ::: "memory"); else if (s0 + 3 < NHS) asm volatile("s_waitcnt vmcnt(42)" ::: "memory"); else asm volatile("s_waitcnt vmcnt(32)" ::: "memory");
        WG_BAR();
        if (s0 + 4 < NHS) SCAN_DMA(s0 + 4);
        if ((n & 1) == 0) SCAN_MMA(1); else SCAN_MMA(3);
    }
    SCAN_STORE(RET_NC - 1);
#undef SCAN_DMA
#undef SCAN_MMA
#undef SCAN_STORE
}
}

__device__ __forceinline__ int memattn_owned_unit(int x, int r) { return (((x >> 1) * 4 + (r >> 3)) * 16) + 8 * (x & 1) + (r & 7); }

#ifndef MK_PHASE_MASK
#define MK_PHASE_MASK 0xffffffffu
#endif
#define PH(k) ((MK_PHASE_MASK >> (k)) & 1u)
#ifndef MK_DUP_MASK
#define MK_DUP_MASK 0u
#endif
#ifndef WGM_IN
#define WGM_IN 4
#endif
#ifndef WGM_O
#define WGM_O 4
#endif
#ifndef WGM_UP
#define WGM_UP 8
#endif
#ifndef WGM_DOWN
#define WGM_DOWN 4
#endif
#ifndef MK_LOCAL_SEAMS
#define MK_LOCAL_SEAMS 1
#endif
#ifndef MK_PROBE_PRE
#define MK_PROBE_PRE 0
#endif
#ifndef MK_DUP_NULL
#define MK_DUP_NULL 0
#endif
#define DUP(k) ((int)((MK_DUP_MASK >> (k)) & 1u))
struct Args { const float* in[N_IN]; float* out; unsigned char* ws; int lo, hi, one, pad; };
struct LayerP { const float *norm_mix, *w_in, *extra, *w_mem_kv, *w_o, *norm_ffn, *w_up, *conv_w, *conv_b, *w_down; int kind, nin; };
__device__ __forceinline__ LayerP get_layer(const Args& a, int l) {
    LayerP p; const int kind = l % 3; const int base = (l == 0) ? 3 : (l == 1) ? 13 : (l == 2) ? 23 : 32; int i = base;
    p.kind = kind; p.norm_mix = a.in[i++]; p.w_in = a.in[i++]; p.extra = nullptr; if (kind != 2) p.extra = a.in[i++];
    p.w_mem_kv = a.in[i++]; p.w_o = a.in[i++]; p.norm_ffn = a.in[i++]; p.w_up = a.in[i++]; p.conv_w = a.in[i++]; p.conv_b = a.in[i++]; p.w_down = a.in[i++];
    p.nin = (kind == 0) ? 4 * MIXW + MEMW : 3 * MIXW + MEMW; return p;
}

__global__ void __launch_bounds__(NTHREADS, 2) mk_fwd(Args a) {
    extern __shared__ __attribute__((aligned(16))) unsigned char lds_raw[];
    lds_t* lds = (lds_t*)lds_raw;
    volatile LAS unsigned* MISC = (volatile LAS unsigned*)(lds + MISC_OFF);
    const int wave_s = __builtin_amdgcn_readfirstlane((int)threadIdx.x >> 6);
    const int tid = mk_tid(wave_s);
    const int G = gridDim.x, bx = blockIdx.x;
    const int vcu = (G % 8 == 0) ? (bx % 8) * (G / 8) + bx / 8 : bx;
    const int ngw = G * NWAVES;
    unsigned char* ws = a.ws;
    unsigned* ctl = (unsigned*)(ws + WS_CTL);
    pg8::rsq_t* rowsq = (pg8::rsq_t*)(ws + WS_ROWSQ);
    float* kmean = (float*)(ws + WS_KMEAN);
    bf16* WmemT = (bf16*)(ws + WS_WMEMKV);
    bf16* XB = (bf16*)(ws + WS_XB); bf16* MEMN = (bf16*)(ws + WS_MEMN); bf16* MEMKV = (bf16*)(ws + WS_MEMKV);
    bf16* PROJ = (bf16*)(ws + WS_PROJ); bf16* CAT = (bf16*)(ws + WS_CAT); bf16* SBUF = (bf16*)(ws + WS_SBUF);
    bf16* ACT = (bf16*)(ws + WS_ACT); float* HALO = (float*)(ws + WS_HALO);
    float* X = a.out;
    if (tid < 64) MISC[tid] = 0u;
    __syncthreads();
    XcdBarrier bar; bar.bar = ctl + CW_BAR; bar.x = 0; bar.st = nullptr;
    if (a.one) { bar = xcd_barrier_post(ctl + CW_BAR, MISC + 8); if (tid == 0) __hip_atomic_fetch_or(ctl + CW_VER + (bx & 7), 1u << bar.x, __ATOMIC_RELAXED, __HIP_MEMORY_SCOPE_AGENT); }
    bool local_ok = false;
    int step = 0;
#define RUN_STEP (step >= a.lo && step < a.hi)
#define PHASE_IDS() const int tidp = mk_tid(wave_s); const int lanep = tidp & 63; const int wavep = wave_s; const int gwp = vcu * NWAVES + wavep; (void)lanep; (void)gwp
#define SEAM() do { if (a.one) xcd_barrier(bar); ++step; } while (0)
#define SEAM_NOBAR() do { ++step; } while (0)
#define SEAM_LOCAL() do { if (a.one) { if (local_ok) xcd_local_barrier(bar, ctl + CW_LBAR); else xcd_barrier(bar); } ++step; } while (0)

    if (RUN_STEP && PH(0)) for (int rp = 0; rp <= DUP(0); ++rp) {
        PHASE_IDS();
        for (int l = DEPTH - 1; l >= 0; --l) { const LayerP p = get_layer(a, l); unsigned char* wl = ws + WS_WL + (size_t)l * WL_STRIDE;
            convert_matrix(p.w_mem_kv, DM, 2 * MEMW, WmemT + (size_t)l * 1024 * DM, nullptr, lds, gwp, ngw, wavep, lanep);
            convert_matrix(p.w_in, DM, p.nin, (bf16*)(wl + WL_IN), p.norm_mix, lds, gwp, ngw, wavep, lanep);
            convert_matrix(p.w_o, DM, DM, (bf16*)(wl + WL_O), nullptr, lds, gwp, ngw, wavep, lanep);
            convert_matrix<true>(p.w_up, DM, 2 * DFF, (bf16*)(wl + WL_UP), p.norm_ffn, lds, gwp, ngw, wavep, lanep);
            convert_matrix(p.w_down, DFF, DM, (bf16*)(wl + WL_DOWN), nullptr, lds, gwp, ngw, wavep, lanep); }
        { const bool xown = (G == 256);
          for (int m = xown ? (bx & 7) * 2048 + ((bx >> 3) * NWAVES + wavep) : gwp; m < (xown ? (bx & 7) * 2048 + 2048 : M); m += (xown ? 256 : ngw)) x_row_prologue(a.in[0] + (size_t)m * DM, XB + (size_t)m * DM, rowsq + m, lanep); }
        for (int m = gwp; m < MEMROWS; m += ngw) norm_row_bf16(a.in[1] + (size_t)m * DM, a.in[2], MEMN + (size_t)m * DM, lanep);
        for (int i = gwp * 64 + lanep; i < DEPTH * 4 * 2 * DFF; i += ngw * 64) { const int l = i / (4 * 2 * DFF), r = (i / (2 * DFF)) & 3, n = i % (2 * DFF); const LayerP p = get_layer(a, l);
            const float v = (r < 3) ? p.conv_w[(size_t)r * 2 * DFF + n] : p.conv_b[n];
            ((float*)(ws + WS_CONVS))[i] = v * (n < DFF ? -1.4426950408889634f : -0.6931471805599453f); }
    }
    SEAM();
    if (a.one && MK_LOCAL_SEAMS) {
        if (tid == 0) { bool ok = (G == 256);
            for (int r = 0; r < 8; ++r) { const unsigned m = __hip_atomic_load(ctl + CW_VER + r, __ATOMIC_RELAXED, __HIP_MEMORY_SCOPE_AGENT); ok = ok && m != 0u && (m & (m - 1u)) == 0u; }
            MISC[20] = ok ? 1u : 0u; }
        __syncthreads();
        local_ok = MISC[20] != 0u;
    }
    if (RUN_STEP && PH(1)) for (int rp = 0; rp <= DUP(1); ++rp) {
        pg8::Gemm g{MEMN, WmemT, MEMROWS, 4 * 2 * MEMW, DM}; pg8::StaticOrder S; S.init(MEMROWS, 4 * 2 * MEMW, G, (bx + 128) % G);
        pg8::EpiScaleBf16 E{MEMKV, 4 * 2 * MEMW, nullptr, 0, 0, nullptr, lds + 139264};
        pg8::gemm_phase<pg8::EpiScaleBf16, pg8::StaticOrder, true, true>(wave_s, lds, g, S, E);
    }
    SEAM_NOBAR();

#pragma unroll 1
    for (int l = 0; l < DEPTH; ++l) {
        const LayerP p = get_layer(a, l);
        const int kind = p.kind, nin = p.nin;
        pg8::rsq_t* rsq_mix = rowsq + (size_t)(2 * l) * M; pg8::rsq_t* rsq_ffn = rowsq + (size_t)(2 * l + 1) * M; pg8::rsq_t* rsq_next = rowsq + (size_t)(2 * l + 2) * M;
        unsigned char* wl = ws + WS_WL + (size_t)l * WL_STRIDE;
        bf16* WinT = (bf16*)(wl + WL_IN); bf16* WoT = (bf16*)(wl + WL_O); bf16* WupT = (bf16*)(wl + WL_UP); bf16* WdownT = (bf16*)(wl + WL_DOWN);
        if (RUN_STEP && PH(3)) for (int rp = 0; rp <= DUP(3); ++rp) {
            pg8::Gemm g{XB, WinT, M, nin, DM}; pg8::StaticOrder S; S.init(M, nin, G, bx, WGM_IN);
            if (MK_DUP_NULL && rp < DUP(3)) { pg8::EpiNull E0{(float*)(ws + WS_SCRRSQ)}; if (MK_DUP_NULL == 2) g.kst = 0; pg8::gemm_phase<pg8::EpiNull, pg8::StaticOrder, true, true>(wave_s, lds, g, S, E0); continue; }
            pg8::EpiScaleBf16 E{PROJ, nin, rsq_mix, kind == 0 ? 1 : (kind == 2 ? 2 : 0), kind == 0 ? 12 : 6, kmean, lds + 139264};
            pg8::gemm_phase<pg8::EpiScaleBf16, pg8::StaticOrder, true, true>(wave_s, lds, g, S, E);
        }
        SEAM();
        if (RUN_STEP) {
            int bxl = bx; asm volatile("" : "+s"(bxl));
            const bool xdeal = (G == 256); const int xcd = bxl & 7, rank = bxl >> 3;
            if (kind == 0 && PH(4)) for (int rp = 0; rp <= DUP(4); ++rp) {
                if (xdeal) { if (rank < 24) { const int es = rank & 7, b = xcd >> 1, h = 3 * (xcd & 1) + (rank >> 3);
                    att::scan_item(wave_s, PROJ, nin, SBUF, b, h, es, pg8::ret_lg2g(h), lds); __syncthreads(); } }
                else for (int it = bx; it < BATCH * RET_H * 8; it += G) { const int es = it & 7, bh = it >> 3, b = bh / RET_H, h = bh % RET_H;
                    att::scan_item(wave_s, PROJ, nin, SBUF, b, h, es, pg8::ret_lg2g(h), lds); __syncthreads(); }
            }
            if (kind == 0 && PH(9)) for (int v = (xdeal ? (rank >= 24 ? rank - 24 : -1) : bx); v >= 0 && v < (xdeal ? 32 : BATCH * 4 * (SEQ / 256)); v += (xdeal ? 8 : G)) { const int u = xdeal ? memattn_owned_unit(xcd, v) : v, qb = u % (SEQ / 256), bhh = u / (SEQ / 256), b = bhh >> 2, hh = bhh & 3;
                const bf16* Qb = PROJ + ((size_t)b * SEQ + (size_t)qb * 256) * nin + (nin - MEMW) + hh * 128;
                const bf16* Kb = MEMKV + ((size_t)b * MEMT) * 4096 + l * 1024 + hh * 128; const bf16* Vb = Kb + MEMW;
                att::attn_unit<false>(wave_s, Qb, nin, Kb, Vb, 4096, CAT + ((size_t)b * SEQ + (size_t)qb * 256) * DM + MIXW + hh * 128, DM, MEMT / 64, 0, 0.f, nullptr, lds); }
        }
        if (kind == 0) SEAM_LOCAL(); else SEAM_NOBAR();
        if (RUN_STEP) {
            if (kind == 0 && PH(6)) for (int rp = 0; rp <= DUP(6); ++rp) {
                const bool xdeal = (G == 256);
                int bxl = bx; asm volatile("" : "+s"(bxl));
                for (int it = bxl; it < BATCH * RET_H * RET_NC; it += G) { const int n = xdeal ? (bxl >> 3) : it % RET_NC, bh = xdeal ? ((bxl & 7) >> 1) * RET_H + 3 * (bxl & 1) + (it >> 8) : it / RET_NC, b = bh / RET_H, h = bh % RET_H;
                    att::ret_unit(wave_s, PROJ, nin, SBUF + ((size_t)(bh * RET_NC + n) * 256) * 256, p.extra, CAT, b, h, n, pg8::ret_lg2g(h), lds); }
            } else if (kind == 1 && PH(7)) for (int rp = 0; rp <= DUP(7); ++rp) {
                const float* cw = p.extra; PHASE_IDS();
                const bool xown = (G == 256); const size_t id0 = xown ? (size_t)(bx >> 3) * NTHREADS + tidp : (size_t)bx * NTHREADS + tidp, idn = xown ? (size_t)2048 * (MIXW / 8) : (size_t)M * (MIXW / 8), ids = xown ? (size_t)32 * NTHREADS : (size_t)G * NTHREADS;
                for (size_t id = id0; id < idn; id += ids) {
                    const size_t row = (xown ? (size_t)(bx & 7) * 2048 : 0) + id / (MIXW / 8); const int ch = (int)(id % (MIXW / 8)), c0 = ch * 8, t = (int)(row & (SEQ - 1));
                    const bf16* pr = PROJ + row * nin + c0;
                    const u32x4 Bv = *(const u32x4*)pr, C0 = *(const u32x4*)(pr + MIXW), H0 = *(const u32x4*)(pr + 2 * MIXW);
                    u32x4 C1 = {0, 0, 0, 0}, H1 = C1, C2 = C1, H2 = C1;
                    if (t >= 1) { C1 = *(const u32x4*)(pr - nin + MIXW); H1 = *(const u32x4*)(pr - nin + 2 * MIXW); }
                    if (t >= 2) { C2 = *(const u32x4*)(pr - 2 * nin + MIXW); H2 = *(const u32x4*)(pr - 2 * nin + 2 * MIXW); }
                    float w0[8], w1[8], w2[8];
                    { const f32x4 a0 = *(const f32x4*)(cw + c0), a1 = *(const f32x4*)(cw + c0 + 4), b0 = *(const f32x4*)(cw + MIXW + c0), b1 = *(const f32x4*)(cw + MIXW + c0 + 4), d0 = *(const f32x4*)(cw + 2 * MIXW + c0), d1 = *(const f32x4*)(cw + 2 * MIXW + c0 + 4);
#pragma unroll
                      for (int i = 0; i < 4; ++i) { w0[i] = a0[i]; w0[4 + i] = a1[i]; w1[i] = b0[i]; w1[4 + i] = b1[i]; w2[i] = d0[i]; w2[4 + i] = d1[i]; } }
                    u32x4 ov;
#pragma unroll
                    for (int q = 0; q < 4; ++q) {
                        const float ylo = bflo(Bv[q]) * (w0[2 * q] * bflo(C2[q]) * bflo(H2[q]) + w1[2 * q] * bflo(C1[q]) * bflo(H1[q]) + w2[2 * q] * bflo(C0[q]) * bflo(H0[q]));
                        const float yhi = bfhi(Bv[q]) * (w0[2 * q + 1] * bfhi(C2[q]) * bfhi(H2[q]) + w1[2 * q + 1] * bfhi(C1[q]) * bfhi(H1[q]) + w2[2 * q + 1] * bfhi(C0[q]) * bfhi(H0[q]));
                        ov[q] = pk2(ylo, yhi); }
                    *(u32x4*)(CAT + row * DM + c0) = ov;
                }
            } else if (kind == 2 && PH(8)) {
                PHASE_IDS();
                const bool shard = (G % 8 == 0); const int qx = bx & 7;
                const int NQ = shard ? 128 : BATCH * MOBA_H * MOBA_NB + BATCH * 4 * (SEQ / 256);
                unsigned* qhead = ctl + CW_QUEUE + 8 * l + (shard ? qx : 0);
                unsigned nextL = 0u;
                if (tidp == 0) nextL = __hip_atomic_fetch_add(qhead, 1u, __ATOMIC_RELAXED, __HIP_MEMORY_SCOPE_AGENT);
                for (;;) {
                    if (tidp == 0) MISC[16] = nextL;
                    __syncthreads();
                    const int L = (int)MISC[16];
                    __syncthreads();
                    if (L >= NQ) break;
                    if (tidp == 0) nextL = __hip_atomic_fetch_add(qhead, 1u, __ATOMIC_RELAXED, __HIP_MEMORY_SCOPE_AGENT);
                    if (L < (shard ? 96 : BATCH * MOBA_H * MOBA_NB)) {
                        const int qb = shard ? (MOBA_NB - 1) - L / 6 : (MOBA_NB - 1) - L / (BATCH * MOBA_H), bh = shard ? qx + 8 * (L % 6) : L % (BATCH * MOBA_H), b = bh / MOBA_H, h = bh % MOBA_H;
                        const float slope = (h < 8) ? __builtin_amdgcn_exp2f(-(float)(h + 1)) : __builtin_amdgcn_exp2f(-0.5f - (float)(h - 8));
                        const bf16* Qb = PROJ + ((size_t)b * SEQ + (size_t)qb * 256) * nin + h * 128;
                        const bf16* Kb = PROJ + ((size_t)b * SEQ) * nin + MIXW + h * 128; const bf16* Vb = Kb + MIXW;
                        att::attn_unit<true>(wave_s, Qb, nin, Kb, Vb, nin, CAT + ((size_t)b * SEQ + (size_t)qb * 256) * DM + h * 128, DM, 4 * (qb + 1), qb, slope * 1.4426950408889634f,
                                             kmean + (size_t)(b * MOBA_H + h) * MOBA_NB * 128, lds);
                    } else {
                        const int u = shard ? memattn_owned_unit(qx, L - 96) : L - BATCH * MOBA_H * MOBA_NB, qb = u % (SEQ / 256), bhh = u / (SEQ / 256), b = bhh >> 2, hh = bhh & 3;
                        const bf16* Qb = PROJ + ((size_t)b * SEQ + (size_t)qb * 256) * nin + (nin - MEMW) + hh * 128;
                        const bf16* Kb = MEMKV + ((size_t)b * MEMT) * 4096 + l * 1024 + hh * 128; const bf16* Vb = Kb + MEMW;
                        att::attn_unit<false>(wave_s, Qb, nin, Kb, Vb, 4096, CAT + ((size_t)b * SEQ + (size_t)qb * 256) * DM + MIXW + hh * 128, DM, MEMT / 64, 0, 0.f, nullptr, lds);
                    }
                }
            }
            if (PH(9) && kind == 1) for (int rp = 0; rp <= DUP(9); ++rp) for (int v = bx; v < BATCH * 4 * (SEQ / 256); v += G) { const int u = (G == 256) ? memattn_owned_unit(v & 7, v >> 3) : v, qb = u % (SEQ / 256), bhh = u / (SEQ / 256), b = bhh >> 2, hh = bhh & 3;
                const bf16* Qb = PROJ + ((size_t)b * SEQ + (size_t)qb * 256) * nin + (nin - MEMW) + hh * 128;
                const bf16* Kb = MEMKV + ((size_t)b * MEMT) * 4096 + l * 1024 + hh * 128; const bf16* Vb = Kb + MEMW;
                att::attn_unit<false>(wave_s, Qb, nin, Kb, Vb, 4096, CAT + ((size_t)b * SEQ + (size_t)qb * 256) * DM + MIXW + hh * 128, DM, MEMT / 64, 0, 0.f, nullptr, lds); }
        }
        if (kind == 1) SEAM_LOCAL(); else SEAM();
        if (RUN_STEP && PH(10)) for (int rp = 0; rp <= DUP(10); ++rp) { const bool scr = rp < DUP(10);
            pg8::Gemm g{CAT, WoT, M, DM, DM}; pg8::StaticOrder S; S.init(M, DM, G, bx, WGM_O);
            if (MK_DUP_NULL && scr) { pg8::EpiNull E0{(float*)(ws + WS_SCRRSQ)}; pg8::gemm_phase<pg8::EpiNull, pg8::StaticOrder, true, true>(wave_s, lds, g, S, E0); continue; }
            pg8::EpiRes E{XB, scr ? (bf16*)(ws + WS_SCRXB) : XB, scr ? (pg8::rsq_t*)(ws + WS_SCRRSQ) : rsq_ffn};
            pg8::gemm_phase<pg8::EpiRes, pg8::StaticOrder, true, true>(wave_s, lds, g, S, E);
            if (MK_PROBE_PRE && !scr) { pg8::Gemm g2{XB, WupT, M, 2 * DFF, DM}; pg8::StaticOrder S2; S2.init(M, 2 * DFF, G, bx); pg8::EpiNull E0{(float*)(ws + WS_SCRRSQ)}; pg8::gemm_phase<pg8::EpiNull, pg8::StaticOrder, true, true>(wave_s, lds, g2, S2, E0); }
        }
        SEAM_LOCAL();
        if (RUN_STEP && PH(11)) for (int rp = 0; rp <= DUP(11); ++rp) {
            pg8::Gemm g{XB, WupT, M, 2 * DFF, DM}; pg8::StaticOrder S; S.init(M, 2 * DFF, G, bx, WGM_UP);
            if (MK_DUP_NULL && rp < DUP(11)) { pg8::EpiNull E0{(float*)(ws + WS_SCRRSQ)}; pg8::gemm_phase<pg8::EpiNull, pg8::StaticOrder, true, true>(wave_s, lds, g, S, E0); continue; }
            const float* cws = (const float*)(ws + WS_CONVS) + (size_t)l * 4 * 2 * DFF;
            pg8::EpiUpConv E{ACT, DFF, rsq_ffn, cws, cws + 3 * 2 * DFF, HALO, lds + 131072, lds + 139264};
            pg8::gemm_phase<pg8::EpiUpConv, pg8::StaticOrder, true, true>(wave_s, lds, g, S, E);
        }
        SEAM();
        if (RUN_STEP && PH(12)) for (int rp = 0; rp <= DUP(12); ++rp) {
            const float* cw = p.conv_w; const float* cb = p.conv_b; PHASE_IDS();
            constexpr int NCH = DFF / 8, N2 = 2 * DFF;
            const bool xown = (G == 256);
            for (int id = xown ? (bx >> 3) * NTHREADS + tidp : bx * NTHREADS + tidp; id < (xown ? 8 : M / 256) * NCH; id += (xown ? 32 : G) * NTHREADS) {
                const int pm = (xown ? 8 * (bx & 7) : 0) + id / NCH, ch0 = (id % NCH) * 8; if ((pm & 15) == 0) continue;
                const int pn = ch0 >> 7, j = ch0 & 127, gc = pn * 256 + j;
                const float* hp = HALO + (size_t)(pm - 1) * 4 * N2 + 2 * N2 + gc;
                float G4[4][8], U4[4][8];
#pragma unroll
                for (int r = 0; r < 4; ++r) { const f32x4 g0 = *(const f32x4*)(hp + (size_t)r * N2), g1 = *(const f32x4*)(hp + (size_t)r * N2 + 4), u0 = *(const f32x4*)(hp + (size_t)r * N2 + 128), u1 = *(const f32x4*)(hp + (size_t)r * N2 + 132);
#pragma unroll
                    for (int i = 0; i < 4; ++i) { G4[r][i] = g0[i]; G4[r][4 + i] = g1[i]; U4[r][i] = u0[i]; U4[r][4 + i] = u1[i]; } }
                float wg[3][8], wu[3][8], bg[8], bu[8];
#pragma unroll
                for (int k = 0; k < 3; ++k) { const f32x4 a0 = *(const f32x4*)(cw + k * N2 + ch0), a1 = *(const f32x4*)(cw + k * N2 + ch0 + 4), b0 = *(const f32x4*)(cw + k * N2 + DFF + ch0), b1 = *(const f32x4*)(cw + k * N2 + DFF + ch0 + 4);
#pragma unroll
                    for (int i = 0; i < 4; ++i) { wg[k][i] = a0[i]; wg[k][4 + i] = a1[i]; wu[k][i] = b0[i]; wu[k][4 + i] = b1[i]; } }
                { const f32x4 a0 = *(const f32x4*)(cb + ch0), a1 = *(const f32x4*)(cb + ch0 + 4), b0 = *(const f32x4*)(cb + DFF + ch0), b1 = *(const f32x4*)(cb + DFF + ch0 + 4);
#pragma unroll
                  for (int i = 0; i < 4; ++i) { bg[i] = a0[i]; bg[4 + i] = a1[i]; bu[i] = b0[i]; bu[4 + i] = b1[i]; } }
#pragma unroll
                for (int r = 0; r < 2; ++r) { float av[8];
#pragma unroll
                    for (int i = 0; i < 8; ++i) {
                        const float Gv = wg[0][i] * G4[r][i] + wg[1][i] * G4[r + 1][i] + wg[2][i] * G4[r + 2][i] + bg[i];
                        const float Uv = wu[0][i] * U4[r][i] + wu[1][i] * U4[r + 1][i] + wu[2][i] * U4[r + 2][i] + bu[i];
                        av[i] = silu_f(Gv) * Uv; }
                    u32x4 w; w.x = pk2(av[0], av[1]); w.y = pk2(av[2], av[3]); w.z = pk2(av[4], av[5]); w.w = pk2(av[6], av[7]);
                    *(u32x4*)(ACT + ((size_t)pm * 256 + r) * DFF + ch0) = w; }
            }
        }
        SEAM_LOCAL();
        if (RUN_STEP && PH(13)) for (int rp = 0; rp <= DUP(13); ++rp) { const bool scr = rp < DUP(13);
            pg8::Gemm g{ACT, WdownT, M, DM, DFF}; pg8::StaticOrder S; S.init(M, DM, G, bx, WGM_DOWN);
            if (MK_DUP_NULL && scr) { pg8::EpiNull E0{(float*)(ws + WS_SCRRSQ)}; pg8::gemm_phase<pg8::EpiNull, pg8::StaticOrder, true, true>(wave_s, lds, g, S, E0); continue; }
            pg8::EpiRes E{XB, scr ? (bf16*)(ws + WS_SCRXB) : XB, scr ? (pg8::rsq_t*)(ws + WS_SCRRSQ) : rsq_next};
            pg8::gemm_phase<pg8::EpiRes, pg8::StaticOrder, true, true>(wave_s, lds, g, S, E);
        }
        SEAM_LOCAL();
    }
    if (RUN_STEP && PH(14)) {
        const pg8::rsq_t* rsq = rowsq + (size_t)(2 * DEPTH) * M; const float* gfin = a.in[N_IN - 1]; PHASE_IDS();
        const bool xown = (G == 256);
        for (int m = xown ? (bx & 7) * 2048 + ((bx >> 3) * NWAVES + wavep) : gwp; m < (xown ? (bx & 7) * 2048 + 2048 : M); m += (xown ? 256 : ngw)) { const u32x4* xr = (const u32x4*)(XB + (size_t)m * DM) + lanep; f32x4* orow = (f32x4*)(X + (size_t)m * DM) + 2 * lanep; const f32x4* gr = (const f32x4*)gfin + 2 * lanep;
            const float rs = pg8::rsq_scale(rsq, m);
#pragma unroll
            for (int j = 0; j < 4; ++j) { const u32x4 v = xr[64 * j]; const f32x4 g0 = gr[128 * j], g1 = gr[128 * j + 1];
                orow[128 * j] = (f32x4){bflo(v.x) * rs * g0.x, bfhi(v.x) * rs * g0.y, bflo(v.y) * rs * g0.z, bfhi(v.y) * rs * g0.w};
                orow[128 * j + 1] = (f32x4){bflo(v.z) * rs * g1.x, bfhi(v.z) * rs * g1.y, bflo(v.w) * rs * g1.z, bfhi(v.w) * rs * g1.w}; } }
    }
#undef RUN_STEP
#undef SEAM
#undef SEAM_NOBAR
}
constexpr int NSTEPS = 2 + DEPTH * 7 + 1;

#ifndef MK_ONE_LAUNCH
#define MK_ONE_LAUNCH 1
#endif
extern "C" void kernel_launch(void* const* d_in, const int* in_sizes, int n_in, void* d_out, int out_size, void* d_ws, size_t ws_size, hipStream_t stream) {
    static int grid = 0;
    if (grid == 0) {
        if (n_in != N_IN || in_sizes[0] != M * DM || out_size != M * DM || ws_size < (MK_DUP_MASK ? WS_END_PROBE : WS_END)) { fprintf(stderr, "kernel_launch: unexpected shapes (n_in %d, in0 %d, out %d, ws %zu, need %zu); nothing launched\n", n_in, n_in > 0 ? in_sizes[0] : -1, out_size, ws_size, (size_t)WS_END); grid = -1; return; }
        int dev = 0, cus = 0, per_cu = 0;
        if (hipGetDevice(&dev) != hipSuccess || hipDeviceGetAttribute(&cus, hipDeviceAttributeMultiprocessorCount, dev) != hipSuccess) { grid = -1; return; }
        if (hipFuncSetAttribute((const void*)mk_fwd, hipFuncAttributeMaxDynamicSharedMemorySize, LDS_BYTES) != hipSuccess) { fprintf(stderr, "kernel_launch: hipFuncSetAttribute failed\n"); grid = -1; return; }
        if (hipOccupancyMaxActiveBlocksPerMultiprocessor(&per_cu, (const void*)mk_fwd, NTHREADS, LDS_BYTES) != hipSuccess || per_cu < 1) { fprintf(stderr, "kernel_launch: occupancy query says %d blocks per CU\n", per_cu); }
        (void)hipGetLastError();
        grid = cus;
    }
    if (grid < 0) return;
    if (hipMemsetAsync((char*)d_ws + WS_CTL, 0, CTL_ZERO_BYTES, stream) != hipSuccess) { fprintf(stderr, "kernel_launch: memset failed\n"); return; }
    Args a{};
    for (int i = 0; i < N_IN; ++i) a.in[i] = (const float*)d_in[i];
    a.out = (float*)d_out; a.ws = (unsigned char*)d_ws; a.pad = 0;
    if (MK_ONE_LAUNCH) { a.lo = 0; a.hi = 1 << 20; a.one = 1; hipLaunchKernelGGL(mk_fwd, dim3(grid), dim3(NTHREADS), LDS_BYTES, stream, a); }
    else { for (int s = 0; s < NSTEPS; ++s) { a.lo = s; a.hi = s + 1; a.one = 0; hipLaunchKernelGGL(mk_fwd, dim3(grid), dim3(NTHREADS), LDS_BYTES, stream, a); } }
    const hipError_t le = hipPeekAtLastError();
    if (le != hipSuccess) fprintf(stderr, "kernel_launch: launch failed: %s\n", hipGetErrorName(le));
}
```

```cpp
#include <hip/hip_runtime.h>
#include <cstdio>
#include <cstdint>
namespace pg8 {
#define PG8_LAS __attribute__((address_space(3)))
typedef unsigned short bf16_t;
typedef short bf16x8 __attribute__((ext_vector_type(8)));
typedef float f32x4 __attribute__((ext_vector_type(4)));
typedef unsigned u32x4 __attribute__((ext_vector_type(4)));
constexpr int BM = 256, BK = 64, HALF = 128, HTB = HALF * BK * 2  , STAGE_BYTES = 8 * HTB, NXCD = 8, WGM = 8;

__host__ __device__ __forceinline__ int lds_byte(int r, int c) { const int st = (r >> 4) * 2 + (c >> 5), rr = r & 15, cc = c & 31, ob = rr * 64 + cc * 2; return st * 1024 + (ob ^ (((ob >> 9) & 1) << 5)); }
__host__ __device__ __forceinline__ void stage_rc(int b, int& R, int& C) { const int st = b / 1024, sb = b % 1024, swz = sb ^ (((sb >> 9) & 1) << 5); R = (st >> 1) * 16 + swz / 64; C = (st & 1) * 32 + (swz % 64) / 2; }
__host__ __device__ __forceinline__ int perm32(int rho) { const int n = rho >> 4, i = rho & 15; return 8 * (i >> 2) + 4 * n + (i & 3); }

struct Unit { int pm, pn; };
struct Gemm { const bf16_t* A; const bf16_t* Bt; int M, N, K; int kst = BK; };

struct StaticOrder {
    int nM, nN, nwg, G, c, wgm;
    __host__ __device__ void init(int M, int N, int G_, int c_, int wgm_ = WGM) { nM = M / BM; nN = N / BM; nwg = nM * nN; G = G_; c = c_; wgm = wgm_; }
    __host__ __device__ bool next(int i, Unit& u) const {
        const long L = (long)i * G + c; if (L >= nwg) return false;
        int wgid = (int)L; { const int q = nwg / NXCD, r = nwg % NXCD, xcd = wgid % NXCD, off = wgid / NXCD; wgid = (xcd < r ? xcd * (q + 1) : r * (q + 1) + (xcd - r) * q) + off; }
        const int nig = wgm * nN, gid = wgid / nig, fm = gid * wgm, gsz = (nM - fm) < wgm ? (nM - fm) : wgm;
        u.pm = fm + ((wgid % nig) % gsz); u.pn = (wgid % nig) / gsz; return true;
    }
    __device__ __forceinline__ void a_ready(const Unit&) const {}
    __device__ __forceinline__ void done(const Unit&) const {}
};
__device__ __forceinline__ unsigned cvt_pk_bf16(float lo, float hi) { unsigned r; asm volatile("v_cvt_pk_bf16_f32 %0, %1, %2" : "=v"(r) : "v"(lo), "v"(hi)); return r; }
constexpr float RMS_EPS = 1e-6f;
__device__ __forceinline__ float ret_lg2g(int h) {
    const unsigned b = h == 0 ? 0xbd3b9ca6u : h == 1 ? 0xbcba1f74u : h == 2 ? 0xbc3963ddu : h == 3 ? 0xbbb906ceu : h == 4 ? 0xbb38d875u : 0xbab8c154u; return __uint_as_float(b); }
constexpr int EPI_DM = 2048;
constexpr float RSQ_FIX = 16777216.0f, RSQ_INV = 1.0f / 16777216.0f;
typedef unsigned long long rsq_t;
constexpr int EPS_SLOT = 6144, EPS_W = 2048;
__device__ __forceinline__ void eps_dma_rowsq(const rsq_t* rowsq, const Unit& u, int wid, int lane, PG8_LAS unsigned char* slotp) {
    if (wid >= 4 && wid < 6) __builtin_amdgcn_global_load_lds((const unsigned*)(rowsq + (size_t)u.pm * BM + (wid - 4) * 128 + 2 * lane), (PG8_LAS unsigned*)(slotp + (wid - 4) * 1024), 16, 0, 0);
}
__device__ __forceinline__ float eps_row_scale(const PG8_LAS unsigned char* slotp, int row_in_tile) {
    typedef unsigned q2_t __attribute__((ext_vector_type(2)));
    const q2_t q = *(const PG8_LAS q2_t*)(slotp + row_in_tile * 8); const float f = __builtin_fmaf((float)q.y, 4294967296.0f, (float)q.x);
    return __builtin_amdgcn_rsqf(f * (RSQ_INV / EPI_DM) + RMS_EPS); }
__device__ __forceinline__ float rsq_scale(const rsq_t* rowsq, int row) { return __builtin_amdgcn_rsqf((float)rowsq[row] * (RSQ_INV / EPI_DM) + RMS_EPS); }
struct EpiScaleBf16 {
    static constexpr bool PERM = true, AFTER_DRAIN = false, PERM_A = false;
    bf16_t* O; int ldc; const rsq_t* rowsq; int mode, vk_pn0; float* kmean; PG8_LAS unsigned char* eps;
    __device__ __forceinline__ void unit_begin(const Unit& u, int wid, int lane, int slot) const { if (rowsq) eps_dma_rowsq(rowsq, u, wid, lane, eps + slot * EPS_SLOT); }
    __device__ __forceinline__ void operator()(const f32x4 (&acc)[2][2][4][2], const Unit& u, int wr, int wc, int fr, int fq, int slot) const {
        const int row0 = u.pm * BM + wr * 64 + fr, col0 = u.pn * BM + wc * 32 + 8 * fq;
        const int tsel = u.pn - vk_pn0; const bool special = (mode != 0) && tsel >= 0 && tsel < 6;
        const float lg2g = ret_lg2g(tsel);
        f32x4 cs[2][2];
#pragma unroll
        for (int bj = 0; bj < 2; ++bj) { cs[bj][0] = (f32x4){0.f, 0.f, 0.f, 0.f}; cs[bj][1] = cs[bj][0]; }
#pragma unroll
        for (int ai = 0; ai < 2; ++ai)
#pragma unroll
            for (int m = 0; m < 4; ++m) { const int row = row0 + ai * HALF + m * 16; bf16_t* rowp = O + (size_t)row * ldc + col0;
                float s = rowsq ? eps_row_scale(eps + slot * EPS_SLOT, wr * 64 + fr + ai * HALF + m * 16) : 1.0f;
                if (mode == 1 && special) s *= 0.0625f * __builtin_amdgcn_exp2f(lg2g * (float)(127 - (row & 127)));
#pragma unroll
                for (int bj = 0; bj < 2; ++bj) { const f32x4 v0 = acc[ai][bj][m][0] * s, v1 = acc[ai][bj][m][1] * s;
                    if (mode == 2) { cs[bj][0] += v0; cs[bj][1] += v1; }
                    u32x4 w; w.x = cvt_pk_bf16(v0[0], v0[1]); w.y = cvt_pk_bf16(v0[2], v0[3]); w.z = cvt_pk_bf16(v1[0], v1[1]); w.w = cvt_pk_bf16(v1[2], v1[3]);
                    *(u32x4*)(rowp + bj * HALF) = w; } }
        if (mode == 2 && special) {
            const int b = u.pm >> 4, blk = u.pm & 15;
#pragma unroll
            for (int bj = 0; bj < 2; ++bj)
#pragma unroll
                for (int n = 0; n < 2; ++n)
#pragma unroll
                    for (int i = 0; i < 4; ++i) { float c = cs[bj][n][i]; c += __shfl_xor(c, 1); c += __shfl_xor(c, 2); c += __shfl_xor(c, 4); c += __shfl_xor(c, 8);
                        if (fr == 0) { const int cc = tsel * 256 + bj * HALF + wc * 32 + 8 * fq + 4 * n + i;
                            __hip_atomic_fetch_add(kmean + ((size_t)((b * 12 + (cc >> 7)) * 16 + blk)) * 128 + (cc & 127), c * (1.0f / 256.0f), __ATOMIC_RELAXED, __HIP_MEMORY_SCOPE_AGENT); } }
        }
    }
};
struct EpiRes {
    static constexpr bool PERM = true, AFTER_DRAIN = false, PERM_A = false;
    const bf16_t* base; bf16_t* out; rsq_t* rowsq;
    __device__ __forceinline__ void unit_begin(const Unit&, int, int, int) const {}
    __device__ __forceinline__ void operator()(const f32x4 (&acc)[2][2][4][2], const Unit& u, int wr, int wc, int fr, int fq, int) const {
        const int row0 = u.pm * BM + wr * 64 + fr, col0 = u.pn * BM + wc * 32 + 8 * fq;
        u32x4 bva[2][4][2];
#pragma unroll
        for (int ai = 0; ai < 2; ++ai)
#pragma unroll
            for (int m = 0; m < 4; ++m)
#pragma unroll
                for (int bj = 0; bj < 2; ++bj) bva[ai][m][bj] = *(const u32x4*)(base + (size_t)(row0 + ai * HALF + m * 16) * EPI_DM + col0 + bj * HALF);
#pragma unroll
        for (int ai = 0; ai < 2; ++ai) {
            const u32x4 (&bv)[4][2] = bva[ai];
#pragma unroll
            for (int m = 0; m < 4; ++m) { const int row = row0 + ai * HALF + m * 16; const size_t off = (size_t)row * EPI_DM + col0; float ss = 0.f;
#pragma unroll
                for (int bj = 0; bj < 2; ++bj) { const u32x4 b = bv[m][bj];
                    const f32x4 b0 = (f32x4){__uint_as_float(b.x << 16), __uint_as_float(b.x & 0xffff0000u), __uint_as_float(b.y << 16), __uint_as_float(b.y & 0xffff0000u)};
                    const f32x4 b1 = (f32x4){__uint_as_float(b.z << 16), __uint_as_float(b.z & 0xffff0000u), __uint_as_float(b.w << 16), __uint_as_float(b.w & 0xffff0000u)};
                    const f32x4 v0 = b0 + acc[ai][bj][m][0], v1 = b1 + acc[ai][bj][m][1];
                    ss += (v0[0] * v0[0] + v0[1] * v0[1]) + (v0[2] * v0[2] + v0[3] * v0[3]) + (v1[0] * v1[0] + v1[1] * v1[1]) + (v1[2] * v1[2] + v1[3] * v1[3]);
                    u32x4 w; w.x = cvt_pk_bf16(v0[0], v0[1]); w.y = cvt_pk_bf16(v0[2], v0[3]); w.z = cvt_pk_bf16(v1[0], v1[1]); w.w = cvt_pk_bf16(v1[2], v1[3]);
                    *(u32x4*)(out + off + bj * HALF) = w; }
                ss += __shfl_xor(ss, 16); ss += __shfl_xor(ss, 32);
                if (fq == 0) __hip_atomic_fetch_add(rowsq + row, (rsq_t)(ss * RSQ_FIX), __ATOMIC_RELAXED, __HIP_MEMORY_SCOPE_AGENT); }
            asm volatile("" ::: "memory"); }
    }
};
__device__ __forceinline__ float dpp_ror1(float v) { return __builtin_bit_cast(float, __builtin_amdgcn_update_dpp(__builtin_bit_cast(int, v), __builtin_bit_cast(int, v), 0x121, 0xF, 0xF, false)); }
__device__ __forceinline__ float dpp_ror2(float v) { return __builtin_bit_cast(float, __builtin_amdgcn_update_dpp(__builtin_bit_cast(int, v), __builtin_bit_cast(int, v), 0x122, 0xF, 0xF, false)); }
__device__ __forceinline__ void conv_taps4(f32x4& o, const f32x4& cur, const f32x4& prv, const f32x4& w2, const f32x4& w1, const f32x4& w0, const f32x4& bb) {
    float o0, o1, o2, o3;
    asm("v_fma_f32 %0, %4, %20, %24\n\t"
        "v_fma_f32 %1, %5, %21, %25\n\t"
        "v_fma_f32 %2, %6, %22, %26\n\t"
        "v_fma_f32 %3, %7, %23, %27\n\t"
        "v_fmac_f32_dpp %0, %4, %12 row_shr:1 row_mask:0xf bank_mask:0xf\n\t"
        "v_fmac_f32_dpp %1, %5, %13 row_shr:1 row_mask:0xf bank_mask:0xf\n\t"
        "v_fmac_f32_dpp %2, %6, %14 row_shr:1 row_mask:0xf bank_mask:0xf\n\t"
        "v_fmac_f32_dpp %3, %7, %15 row_shr:1 row_mask:0xf bank_mask:0xf\n\t"
        "v_fmac_f32_dpp %0, %8, %12 row_shl:15 row_mask:0xf bank_mask:0xf\n\t"
        "v_fmac_f32_dpp %1, %9, %13 row_shl:15 row_mask:0xf bank_mask:0xf\n\t"
        "v_fmac_f32_dpp %2, %10, %14 row_shl:15 row_mask:0xf bank_mask:0xf\n\t"
        "v_fmac_f32_dpp %3, %11, %15 row_shl:15 row_mask:0xf bank_mask:0xf\n\t"
        "v_fmac_f32_dpp %0, %4, %16 row_shr:2 row_mask:0xf bank_mask:0xf\n\t"
        "v_fmac_f32_dpp %1, %5, %17 row_shr:2 row_mask:0xf bank_mask:0xf\n\t"
        "v_fmac_f32_dpp %2, %6, %18 row_shr:2 row_mask:0xf bank_mask:0xf\n\t"
        "v_fmac_f32_dpp %3, %7, %19 row_shr:2 row_mask:0xf bank_mask:0xf\n\t"
        "v_fmac_f32_dpp %0, %8, %16 row_shl:14 row_mask:0xf bank_mask:0xf\n\t"
        "v_fmac_f32_dpp %1, %9, %17 row_shl:14 row_mask:0xf bank_mask:0xf\n\t"
        "v_fmac_f32_dpp %2, %10, %18 row_shl:14 row_mask:0xf bank_mask:0xf\n\t"
        "v_fmac_f32_dpp %3, %11, %19 row_shl:14 row_mask:0xf bank_mask:0xf"
        : "=&v"(o0), "=&v"(o1), "=&v"(o2), "=&v"(o3)
        : "v"(cur[0]), "v"(cur[1]), "v"(cur[2]), "v"(cur[3]), "v"(prv[0]), "v"(prv[1]), "v"(prv[2]), "v"(prv[3]),
          "v"(w1[0]), "v"(w1[1]), "v"(w1[2]), "v"(w1[3]), "v"(w0[0]), "v"(w0[1]), "v"(w0[2]), "v"(w0[3]),
          "v"(w2[0]), "v"(w2[1]), "v"(w2[2]), "v"(w2[3]), "v"(bb[0]), "v"(bb[1]), "v"(bb[2]), "v"(bb[3]));
    o[0] = o0; o[1] = o1; o[2] = o2; o[3] = o3;
}
struct EpiUpConv {
    static constexpr bool PERM = true, AFTER_DRAIN = false, PERM_A = true;
    bf16_t* ACT; int dff; const rsq_t* rowsq; const float* cw; const float* cb; float* halo; PG8_LAS unsigned char* xch; PG8_LAS unsigned char* eps;
    __device__ __forceinline__ void unit_begin(const Unit& u, int wid, int lane, int slot) const {
        PG8_LAS unsigned char* sp = eps + slot * EPS_SLOT;
        eps_dma_rowsq(rowsq, u, wid, lane, sp);
        if (wid < 4) { const float* src = (wid < 3 ? cw + (size_t)wid * 2 * dff : cb) + (lane < 32 ? 0 : dff) + u.pn * HALF + (lane & 31) * 4;
            __builtin_amdgcn_global_load_lds((const unsigned*)src, (PG8_LAS unsigned*)(sp + EPS_W + wid * 1024), 16, 0, 0); }
    }
    __device__ __forceinline__ void operator()(f32x4 (&acc)[2][2][4][2], const Unit& u, int wr, int wc, int fr, int fq, int slot) const {
        const PG8_LAS unsigned char* sp = eps + slot * EPS_SLOT;
        const int N2 = 2 * dff;
        const int row0 = u.pm * BM + wr * 64 + fr * 4, colp = u.pn * BM + wc * 32 + 8 * fq, ch0 = u.pn * HALF + wc * 32 + 8 * fq;
        float rs8[2][4];
#pragma unroll
        for (int ai = 0; ai < 2; ++ai)
#pragma unroll
            for (int m = 0; m < 4; ++m) rs8[ai][m] = eps_row_scale(sp, wr * 64 + ai * HALF + fr * 4 + m);
#pragma unroll
        for (int ai = 0; ai < 2; ++ai)
#pragma unroll
            for (int m = 0; m < 4; ++m) { const float s = rs8[ai][m];
#pragma unroll
                for (int bj = 0; bj < 2; ++bj) { acc[ai][bj][m][0] *= s; acc[ai][bj][m][1] *= s; } }
        PG8_LAS float* X = (PG8_LAS float*)xch;
        if (fr == 15) {
#pragma unroll
            for (int ai = 0; ai < 2; ++ai)
#pragma unroll
                for (int w = 0; w < 2; ++w) { PG8_LAS float* xp = X + (((((ai * 2 + wr) * 4 + wc) * 2 + w) * 4 + fq) * 16);
#pragma unroll
                    for (int bj = 0; bj < 2; ++bj) { *(PG8_LAS f32x4*)(xp + (bj * 2 + 0) * 4) = acc[ai][bj][2 + w][0]; *(PG8_LAS f32x4*)(xp + (bj * 2 + 1) * 4) = acc[ai][bj][2 + w][1]; } }
            if (wr == 1) {
#pragma unroll
                for (int w = 0; w < 2; ++w) { float* hp = halo + ((size_t)(u.pm * 4 + 2 + w)) * N2 + colp;
#pragma unroll
                    for (int bj = 0; bj < 2; ++bj) { *(f32x4*)(hp + bj * HALF) = acc[1][bj][2 + w][0]; *(f32x4*)(hp + bj * HALF + 4) = acc[1][bj][2 + w][1]; } } }
        }
        if (wr == 0 && fr == 0) {
#pragma unroll
            for (int w = 0; w < 2; ++w) { float* hp = halo + ((size_t)(u.pm * 4 + w)) * N2 + colp;
#pragma unroll
                for (int bj = 0; bj < 2; ++bj) { *(f32x4*)(hp + bj * HALF) = acc[0][bj][w][0]; *(f32x4*)(hp + bj * HALF + 4) = acc[0][bj][w][1]; } } }
        asm volatile("s_waitcnt lgkmcnt(0)" ::: "memory"); __builtin_amdgcn_s_barrier(); asm volatile("" ::: "memory");
#pragma unroll
        for (int bj = 0; bj < 2; ++bj)
#pragma unroll
            for (int n = 0; n < 2; ++n) {
                const PG8_LAS float* wp = (const PG8_LAS float*)(sp + EPS_W) + bj * HALF + wc * 32 + 8 * fq + 4 * n;
                const f32x4 w0 = *(const PG8_LAS f32x4*)wp, w1 = *(const PG8_LAS f32x4*)(wp + 256), w2 = *(const PG8_LAS f32x4*)(wp + 512), bb = *(const PG8_LAS f32x4*)(wp + 768);
#pragma unroll
                for (int ai = 1; ai >= 0; --ai) {
                    f32x4 l2 = (f32x4){0.f, 0.f, 0.f, 0.f}, l3 = l2;
                    if (wr == 1 || ai == 1) { const int pai = wr == 1 ? ai : ai - 1, pwr = wr == 1 ? 0 : 1;
                        if (fr == 0) { const PG8_LAS float* xq = X + (((((pai * 2 + pwr) * 4 + wc) * 2 + 0) * 4 + fq) * 16) + (bj * 2 + n) * 4; l2 = *(const PG8_LAS f32x4*)xq; l3 = *(const PG8_LAS f32x4*)(xq + 64); } }
                    const f32x4 x0 = acc[ai][bj][0][n], x1 = acc[ai][bj][1][n], x2 = acc[ai][bj][2][n], x3 = acc[ai][bj][3][n];
#pragma unroll
                    for (int i = 0; i < 4; ++i) {
                        float a2 = l2[i], a3 = l3[i];
                        asm volatile("s_nop 1\n\tv_mov_b32_dpp %0, %2 row_shr:1 row_mask:0xf bank_mask:0xf\n\tv_mov_b32_dpp %1, %3 row_shr:1 row_mask:0xf bank_mask:0xf" : "+v"(a2), "+v"(a3) : "v"(x2[i]), "v"(x3[i]));
                        l2[i] = a2; l3[i] = a3; }
                    f32x4 o0 = w2 * x0 + bb, o1 = w2 * x1 + bb, o2 = w2 * x2 + bb, o3 = w2 * x3 + bb;
                    o0 = w1 * l3 + o0; o1 = w1 * x0 + o1; o2 = w1 * x1 + o2; o3 = w1 * x2 + o3;
                    o0 = w0 * l2 + o0; o1 = w0 * l3 + o1; o2 = w0 * x0 + o2; o3 = w0 * x1 + o3;
                    acc[ai][bj][0][n] = o0; acc[ai][bj][1][n] = o1; acc[ai][bj][2][n] = o2; acc[ai][bj][3][n] = o3;
                    asm volatile("" : "+v"(acc[ai][bj][0][n]), "+v"(acc[ai][bj][1][n]), "+v"(acc[ai][bj][2][n]), "+v"(acc[ai][bj][3][n]));
                    __builtin_amdgcn_sched_barrier(0);
                }
            }
#pragma unroll
        for (int ai = 0; ai < 2; ++ai)
#pragma unroll
            for (int m = 0; m < 4; ++m) { const f32x4 g0 = acc[ai][0][m][0], g1 = acc[ai][0][m][1], u0 = acc[ai][1][m][0], u1 = acc[ai][1][m][1];
                const f32x4 t0 = g0, t1 = g1; f32x4 e0, e1;
#pragma unroll
                for (int i = 0; i < 4; ++i) { e0[i] = __builtin_amdgcn_exp2f(t0[i]); e1[i] = __builtin_amdgcn_exp2f(t1[i]); }
                const f32x4 d0 = e0 + 1.0f, d1 = e1 + 1.0f; f32x4 r0, r1;
#pragma unroll
                for (int i = 0; i < 4; ++i) { r0[i] = __builtin_amdgcn_rcpf(d0[i]); r1[i] = __builtin_amdgcn_rcpf(d1[i]); }
                const f32x4 a0 = (g0 * u0) * r0, a1 = (g1 * u1) * r1;
                u32x4 w; w.x = cvt_pk_bf16(a0[0], a0[1]); w.y = cvt_pk_bf16(a0[2], a0[3]); w.z = cvt_pk_bf16(a1[0], a1[1]); w.w = cvt_pk_bf16(a1[2], a1[3]);
                *(u32x4*)(ACT + (size_t)(row0 + ai * HALF + m) * dff + ch0) = w;
                __builtin_amdgcn_sched_barrier(0); }
    }
};
struct EpiNull {
    static constexpr bool PERM = true, AFTER_DRAIN = false, PERM_A = false;
    float* sink;
    __device__ __forceinline__ void unit_begin(const Unit&, int, int, int) const {}
    __device__ __forceinline__ void operator()(const f32x4 (&acc)[2][2][4][2], const Unit& u, int wr, int wc, int fr, int fq, int) const {
        float s = 0.f;
#pragma unroll
        for (int ai = 0; ai < 2; ++ai)
#pragma unroll
            for (int bj = 0; bj < 2; ++bj)
#pragma unroll
                for (int m = 0; m < 4; ++m)
#pragma unroll
                    for (int n = 0; n < 2; ++n) s += acc[ai][bj][m][n][0] + acc[ai][bj][m][n][1] + acc[ai][bj][m][n][2] + acc[ai][bj][m][n][3];
        if (s == 1.2345678e30f) sink[u.pm * 64 + fr] = s;
    }
};
template <class Epi, class Sched, bool ALIGN_EPI = false, bool SP2 = false>
__device__ __forceinline__ void gemm_phase(int wave_s, PG8_LAS unsigned char* lds, const Gemm g, const Sched& S, const Epi& E) {
    int lane_; asm volatile("v_mbcnt_lo_u32_b32 %0, -1, 0\n\tv_mbcnt_hi_u32_b32 %0, -1, %0" : "=v"(lane_)); const int tid_ = wave_s * 64 + lane_;
    const int tid = tid_, wid = __builtin_amdgcn_readfirstlane(tid >> 6), lane = tid & 63, wr = wid >> 2, wc = wid & 3, fr = lane & 15, fq = lane >> 4;
    const int K = g.K, nt = K / BK;
    unsigned voffA[2], voffB[2];
#pragma unroll
    for (int i = 0; i < 2; ++i) { int R, C; stage_rc(tid * 16 + i * 8192, R, C); const int Rb = Epi::PERM ? ((R & ~31) + perm32(R & 31)) : R;
        const int Ra = Epi::PERM_A ? ((R & ~63) + ((R & 15) * 4 + ((R >> 4) & 3))) : R;
        voffA[i] = (unsigned)(Ra * K + C) * 2u; voffB[i] = (unsigned)(Rb * K + C) * 2u; }
    const size_t kstep = (size_t)(g.kst * 2);
    const size_t hstep = (size_t)HALF * K * 2;
    const size_t tstep = 2 * hstep;
    const unsigned ldsw = (unsigned)wid * 1024u;
    const int aoff = lds_byte(wr * 64 + fr, fq * 8), boff = lds_byte(wc * 32 + fr, fq * 8);
#define PG8_SA(b, h) (((b) * 2 + (h)) * HTB)
#define PG8_SB(b, h) ((4 + (b) * 2 + (h)) * HTB)
#define PG8_STAGE(bufoff, gbase, voff) do { _Pragma("unroll") for (int _i = 0; _i < 2; ++_i) \
        __builtin_amdgcn_global_load_lds((const unsigned*)((const char*)(gbase) + (voff)[_i]), (PG8_LAS unsigned*)(lds + (bufoff) + ldsw + _i * 8192), 16, 0, 0); } while (0)
#define PG8_LDA(dst, b, h) do { _Pragma("unroll") for (int m = 0; m < 4; ++m) _Pragma("unroll") for (int k = 0; k < 2; ++k) dst[m][k] = *(const PG8_LAS bf16x8*)(lds + PG8_SA(b, h) + aoff + m * 2048 + k * 1024); } while (0)
#define PG8_LDB(dst, b, h) do { _Pragma("unroll") for (int n = 0; n < 2; ++n) _Pragma("unroll") for (int k = 0; k < 2; ++k) dst[n][k] = *(const PG8_LAS bf16x8*)(lds + PG8_SB(b, h) + boff + n * 2048 + k * 1024); } while (0)
#define PG8_MMA(ai, bj, At, Bt) do { __builtin_amdgcn_s_setprio(1); _Pragma("unroll") for (int m = 0; m < 4; ++m) _Pragma("unroll") for (int n = 0; n < 2; ++n) _Pragma("unroll") for (int k = 0; k < 2; ++k) \
        acc[ai][bj][m][n] = __builtin_amdgcn_mfma_f32_16x16x32_bf16(Bt[n][k], At[m][k], acc[ai][bj][m][n], 0, 0, 0); __builtin_amdgcn_s_setprio(0); } while (0)
#define PG8_WAIT_V(n) asm volatile("s_waitcnt vmcnt(" #n ")" ::: "memory")
#define PG8_WAIT_L(n) asm volatile("s_waitcnt lgkmcnt(" #n ")" ::: "memory")
#define PG8_BAR __builtin_amdgcn_s_barrier()
#define PG8_SCHED __builtin_amdgcn_sched_barrier(0)
    Unit cur, nxt; int ui = 0;
    if (!S.next(0, cur)) return;
    f32x4 acc[2][2][4][2];
#pragma unroll
    for (int a = 0; a < 2; ++a)
#pragma unroll
        for (int b = 0; b < 2; ++b)
#pragma unroll
            for (int m = 0; m < 4; ++m)
#pragma unroll
                for (int n = 0; n < 2; ++n) acc[a][b][m][n] = (f32x4){0.f, 0.f, 0.f, 0.f};
    bf16x8 At[4][2], B0[2][2], B1[2][2];
    const char* cA = (const char*)g.A + (size_t)cur.pm * tstep; const char* cB = (const char*)g.Bt + (size_t)cur.pn * tstep;
    S.a_ready(cur);
    E.unit_begin(cur, wid, lane, 0);
    if constexpr (SP2) {
        PG8_STAGE(PG8_SB(0, 0), cB, voffB); PG8_STAGE(PG8_SB(0, 1), cB + hstep, voffB); PG8_STAGE(PG8_SA(0, 0), cA, voffA); PG8_STAGE(PG8_SA(0, 1), cA + hstep, voffA);
        if (wr == 1) PG8_BAR;
        PG8_WAIT_V(2); PG8_BAR;
        PG8_STAGE(PG8_SB(1, 0), cB + kstep, voffB); PG8_STAGE(PG8_SA(1, 0), cA + kstep, voffA); PG8_STAGE(PG8_SB(1, 1), cB + hstep + kstep, voffB);
        PG8_WAIT_V(6); PG8_BAR;
    } else {
        PG8_STAGE(PG8_SB(0, 0), cB, voffB); PG8_STAGE(PG8_SA(0, 0), cA, voffA); PG8_STAGE(PG8_SB(0, 1), cB + hstep, voffB); PG8_STAGE(PG8_SA(0, 1), cA + hstep, voffA);
        if (wr == 1) PG8_BAR;
        PG8_WAIT_V(4); PG8_BAR;
        PG8_STAGE(PG8_SB(1, 0), cB + kstep, voffB); PG8_STAGE(PG8_SA(1, 0), cA + kstep, voffA); PG8_STAGE(PG8_SB(1, 1), cB + hstep + kstep, voffB);
        PG8_WAIT_V(6); PG8_BAR;
    }
    for (;;) {
        const bool has_next = S.next(ui + 1, nxt);
        const char* nA = has_next ? (const char*)g.A + (size_t)nxt.pm * tstep : cA; const char* nB = has_next ? (const char*)g.Bt + (size_t)nxt.pn * tstep : cB;
        for (int t = 0; t < nt; t += 2) {
            const bool last = (t == nt - 2);
            const char* a1 = cA + (size_t)(t + 1) * kstep;
            const char* a2 = last ? nA : cA + (size_t)(t + 2) * kstep; const char* b2 = last ? nB : cB + (size_t)(t + 2) * kstep;
            const char* a3 = a2 + kstep; const char* b3 = b2 + kstep;
            if (last && has_next) S.a_ready(nxt);
            if constexpr (SP2) {
            PG8_LDB(B0, 0, 0); PG8_LDB(B1, 0, 1); PG8_SCHED; PG8_LDA(At, 0, 0); PG8_STAGE(PG8_SA(1, 1), a1 + hstep, voffA);
            PG8_WAIT_V(8); PG8_WAIT_L(0); PG8_BAR; PG8_MMA(0, 0, At, B0); PG8_MMA(0, 1, At, B1); PG8_BAR; PG8_SCHED;
            PG8_LDA(At, 0, 1); PG8_STAGE(PG8_SB(0, 0), b2, voffB); PG8_STAGE(PG8_SB(0, 1), b2 + hstep, voffB); PG8_STAGE(PG8_SA(0, 0), a2, voffA);
            PG8_WAIT_V(8); PG8_WAIT_L(0); PG8_BAR; PG8_MMA(1, 0, At, B0); PG8_MMA(1, 1, At, B1); PG8_BAR; PG8_SCHED;
            PG8_LDB(B0, 1, 0); PG8_LDB(B1, 1, 1); PG8_SCHED; PG8_LDA(At, 1, 0); PG8_STAGE(PG8_SA(0, 1), a2 + hstep, voffA);
            PG8_WAIT_V(8); PG8_WAIT_L(0); PG8_BAR; PG8_MMA(0, 0, At, B0); PG8_MMA(0, 1, At, B1); PG8_BAR; PG8_SCHED;
            PG8_LDA(At, 1, 1); PG8_STAGE(PG8_SB(1, 0), b3, voffB); PG8_STAGE(PG8_SB(1, 1), b3 + hstep, voffB); PG8_STAGE(PG8_SA(1, 0), a3, voffA);
            PG8_WAIT_V(8); PG8_WAIT_L(0); PG8_BAR; PG8_MMA(1, 0, At, B0); PG8_MMA(1, 1, At, B1); PG8_BAR; PG8_SCHED;
            } else {
            PG8_LDB(B0, 0, 0); PG8_SCHED; PG8_LDA(At, 0, 0); PG8_STAGE(PG8_SA(1, 1), a1 + hstep, voffA);
            PG8_WAIT_L(8); PG8_BAR; PG8_WAIT_L(0); PG8_MMA(0, 0, At, B0); PG8_BAR; PG8_SCHED;
            PG8_LDB(B1, 0, 1); PG8_STAGE(PG8_SB(0, 0), b2, voffB);
            PG8_BAR; PG8_WAIT_L(0); PG8_MMA(0, 1, At, B1); PG8_BAR;
            PG8_LDA(At, 0, 1); PG8_STAGE(PG8_SA(0, 0), a2, voffA);
            PG8_BAR; PG8_WAIT_L(0); PG8_MMA(1, 0, At, B0); PG8_BAR; PG8_SCHED;
            PG8_STAGE(PG8_SB(0, 1), b2 + hstep, voffB);
            PG8_WAIT_V(6); PG8_BAR; PG8_MMA(1, 1, At, B1); PG8_BAR;
            PG8_LDB(B0, 1, 0); PG8_SCHED; PG8_LDA(At, 1, 0); PG8_STAGE(PG8_SA(0, 1), a2 + hstep, voffA);
            PG8_WAIT_L(8); PG8_BAR; PG8_WAIT_L(0); PG8_MMA(0, 0, At, B0); PG8_BAR; PG8_SCHED;
            PG8_LDB(B1, 1, 1); PG8_STAGE(PG8_SB(1, 0), b3, voffB);
            PG8_BAR; PG8_WAIT_L(0); PG8_MMA(0, 1, At, B1); PG8_BAR;
            PG8_LDA(At, 1, 1); PG8_STAGE(PG8_SA(1, 0), a3, voffA);
            PG8_BAR; PG8_WAIT_L(0); PG8_MMA(1, 0, At, B0); PG8_BAR; PG8_SCHED;
            PG8_STAGE(PG8_SB(1, 1), b3 + hstep, voffB);
            PG8_WAIT_V(6); PG8_BAR; PG8_MMA(1, 1, At, B1); PG8_BAR;
            }
        }
        if constexpr (ALIGN_EPI) { if (wr == 0) PG8_BAR; }
        if constexpr (!Epi::AFTER_DRAIN) { E(acc, cur, wr, wc, fr, fq, ui & 1); S.done(cur); }
        if (!has_next) break;
#pragma unroll
        for (int a = 0; a < 2; ++a)
#pragma unroll
            for (int b = 0; b < 2; ++b)
#pragma unroll
                for (int m = 0; m < 4; ++m)
#pragma unroll
                    for (int n = 0; n < 2; ++n) acc[a][b][m][n] = (f32x4){0.f, 0.f, 0.f, 0.f};
        cur = nxt; cA = nA; cB = nB; ++ui;
        E.unit_begin(cur, wid, lane, ui & 1);
        if constexpr (ALIGN_EPI) { if (wr == 1) PG8_BAR; }
    }
    PG8_WAIT_V(0);
    if constexpr (!ALIGN_EPI) { if (wr == 0) PG8_BAR; }
    PG8_BAR;
    if constexpr (Epi::AFTER_DRAIN) { E.fused(acc, cur, wr, wc, fr, fq, lds, wid, lane); S.done(cur); }
#undef PG8_SA
#undef PG8_SB
#undef PG8_STAGE
#undef PG8_LDA
#undef PG8_LDB
#undef PG8_MMA
#undef PG8_WAIT_V
#undef PG8_WAIT_L
#undef PG8_BAR
#undef PG8_SCHED
}
}
constexpr int BATCH = 4, SEQ = 4096, DM = 2048, DEPTH = 4, M = BATCH * SEQ;
constexpr int MEMT = 256, MEMW = 512, MIXW = 1536, DFF = 5632, MEMROWS = BATCH * MEMT;
constexpr int RET_H = 6, RET_C = 128, RET_NC = SEQ / RET_C;
constexpr int MOBA_H = 12, MOBA_NB = SEQ / 256;
constexpr int NWAVES = 8, NTHREADS = 512;
constexpr int N_IN = 43;

constexpr size_t MiB = 1u << 20;
constexpr size_t WS_CTL = 0, CTL_ZERO_BYTES = 2 * MiB;
constexpr size_t WS_ROWSQ = 256 * 1024;
constexpr size_t WS_KMEAN = 1536 * 1024;
constexpr size_t WS_WMEMKV = 3 * MiB;
constexpr size_t WS_WL = 19 * MiB, WL_STRIDE = 100 * MiB;
constexpr size_t WL_IN = 0, WL_O = 26 * MiB, WL_UP = 34 * MiB, WL_DOWN = 78 * MiB;
constexpr size_t WS_XB = 419 * MiB;
constexpr size_t WS_MEMN = 483 * MiB;
constexpr size_t WS_MEMKV = 487 * MiB;
constexpr size_t WS_A = 495 * MiB;
constexpr size_t WS_PROJ = WS_A, WS_CAT = WS_A + 208 * MiB, WS_SBUF = WS_A + 272 * MiB;
constexpr size_t WS_ACT = WS_A + 192 * MiB;
constexpr size_t WS_HALO = WS_A + 368 * MiB;
constexpr size_t WS_CONVS = WS_A + 379 * MiB;
constexpr size_t WS_END = WS_A + 380 * MiB;
constexpr size_t WS_SCRX = WS_A, WS_SCRXB = WS_A + 128 * MiB, WS_SCRRSQ = WS_A + 379 * MiB, WS_END_PROBE = WS_END;
constexpr int CW_QUEUE = 64;
constexpr int CW_VER = 128;
constexpr int CW_LBAR = 8192;
constexpr int CW_BAR = 4096;

constexpr int LDS_BYTES = 163840;
constexpr int MISC_OFF = 163840 - 256;

#define GAS __attribute__((address_space(1)))
#define LAS __attribute__((address_space(3)))
typedef unsigned short bf16;
typedef float f32x4 __attribute__((ext_vector_type(4)));
typedef float f32x16 __attribute__((ext_vector_type(16)));
typedef short bf16x8 __attribute__((ext_vector_type(8)));
typedef short s16x4 __attribute__((ext_vector_type(4)));
typedef unsigned u32x4 __attribute__((ext_vector_type(4)));
typedef unsigned u32x2 __attribute__((ext_vector_type(2)));
typedef LAS unsigned char lds_t;
#define VM_WAIT() asm volatile("s_waitcnt vmcnt(0)" ::: "memory")
#define LDS_WAIT() asm volatile("s_waitcnt lgkmcnt(0)" ::: "memory")
#define SBAR() __builtin_amdgcn_sched_barrier(0)
#define WG_BAR() do { asm volatile("s_waitcnt lgkmcnt(0)" ::: "memory"); __builtin_amdgcn_s_barrier(); asm volatile("" ::: "memory"); } while (0)
__device__ __forceinline__ float bf2f(unsigned short b) { return __uint_as_float(((unsigned)b) << 16); }
__device__ __forceinline__ float bflo(unsigned w) { return __uint_as_float(w << 16); }
__device__ __forceinline__ float bfhi(unsigned w) { return __uint_as_float(w & 0xffff0000u); }
__device__ __forceinline__ unsigned pk2(float lo, float hi) { return pg8::cvt_pk_bf16(lo, hi); }
__device__ __forceinline__ float wave_sum(float v) {
#pragma unroll
    for (int o = 1; o < 64; o <<= 1) v += __shfl_xor(v, o);
    return v;
}
__device__ __forceinline__ int mk_tid(int wave_s) { int l; asm volatile("v_mbcnt_lo_u32_b32 %0, -1, 0\n\tv_mbcnt_hi_u32_b32 %0, -1, %0" : "=v"(l)); return wave_s * 64 + l; }
__device__ __forceinline__ float silu_f(float v) { return v * __builtin_amdgcn_rcpf(1.0f + __builtin_amdgcn_exp2f(-1.4426950408889634f * v)); }

#define XB_TMO      128
#define XB_XCNT(j)  (256  + 64 * (j))
#define XB_XSUB(j)  (1280 + 64 * (j))
#define XB_XGEN(j)  (2304 + 64 * (j))
#define XB_TOP      3328
#define XB_TOPGEN   3392
#define XCD_BAR_WORDS 3456
#define XB_SPIN_CAP (1u << 18)

__device__ __forceinline__ unsigned xb_ld(unsigned* p)              { return __hip_atomic_load(p, __ATOMIC_RELAXED, __HIP_MEMORY_SCOPE_AGENT); }
__device__ __forceinline__ unsigned xb_add(unsigned* p, unsigned v) { return __hip_atomic_fetch_add(p, v, __ATOMIC_RELAXED, __HIP_MEMORY_SCOPE_AGENT); }
__device__ __forceinline__ unsigned xb_xcc_id() { return (unsigned)__builtin_amdgcn_s_getreg((3 << 11) | 20) & 0xFu; }
#define XB_SPIN(cond, bar) do { unsigned _sp = 0; while (cond) { __builtin_amdgcn_s_sleep(1); \
    if ((++_sp & 255u) == 0u) { if (xb_ld(&(bar)[XB_TMO])) break; if (_sp > XB_SPIN_CAP) { atomicAdd(&(bar)[XB_TMO], 1u); break; } } } } while (0)

struct XcdBarrier {
    unsigned* bar; unsigned x;
    volatile LAS unsigned* st;
};

__device__ __forceinline__ XcdBarrier xcd_barrier_post(unsigned* bar, volatile LAS unsigned* st) {
    XcdBarrier b; b.bar = bar; b.x = xb_xcc_id(); b.st = st;
    if (threadIdx.x == 0) (void)xb_add(&bar[XB_XCNT(b.x)], 1u);
    return b;
}
__device__ __forceinline__ void xcd_barrier_complete(unsigned* bar, unsigned x, unsigned& nloc, unsigned& nx) {
    const unsigned G = gridDim.x * gridDim.y * gridDim.z;
    unsigned sum, cnt, mine, sp = 0u;
    for (;;) {
        sum = 0u; cnt = 0u; mine = 0u;
#pragma unroll
        for (unsigned j = 0; j < 16; ++j) { const unsigned c = xb_ld(&bar[XB_XCNT(j)]); sum += c; cnt += (c > 0u) ? 1u : 0u; mine = (j == x) ? c : mine; }
        if (sum == G) break;
        __builtin_amdgcn_s_sleep(1);
        if ((++sp & 255u) == 0u) { if (xb_ld(&bar[XB_TMO])) break; if (sp > XB_SPIN_CAP) { atomicAdd(&bar[XB_TMO], 1u); break; } }
    }
    nloc = mine > 0u ? mine : 1u; nx = cnt > 0u ? cnt : 1u;
}

__device__ __forceinline__ void xcd_barrier(const XcdBarrier& b) {
    asm volatile("s_waitcnt vmcnt(0)" ::: "memory");
    __syncthreads();
    if (threadIdx.x == 0) {
        unsigned* bar = b.bar;
        __builtin_amdgcn_s_waitcnt(0);
        unsigned nloc = b.st[0], nx = b.st[1];
        if (nloc == 0u) { xcd_barrier_complete(bar, b.x, nloc, nx); b.st[0] = nloc; b.st[1] = nx; }
        const unsigned old = xb_add(&bar[XB_XSUB(b.x)], 1u);
        const unsigned gen = old / nloc;
        if (old + 1u == (gen + 1u) * nloc) {
            __builtin_amdgcn_fence(__ATOMIC_RELEASE, "agent");
            asm volatile("s_waitcnt vmcnt(0)" ::: "memory");
            const unsigned og = xb_add(&bar[XB_TOP], 1u);
            const unsigned tg = og / nx;
            if (og + 1u == (tg + 1u) * nx) xb_add(&bar[XB_TOPGEN], 1u);
            else XB_SPIN(xb_ld(&bar[XB_TOPGEN]) == tg, bar);
            __builtin_amdgcn_fence(__ATOMIC_ACQUIRE, "agent");
            xb_add(&bar[XB_XGEN(b.x)], 1u);
            asm volatile("s_waitcnt vmcnt(0)" ::: "memory");
        } else {
            XB_SPIN(xb_ld(&bar[XB_XGEN(b.x)]) == gen, bar);
            __builtin_amdgcn_fence(__ATOMIC_ACQUIRE, "agent");
            asm volatile("s_waitcnt vmcnt(0)" ::: "memory");
        }
    }
    __syncthreads();
}


__device__ __forceinline__ void xcd_local_barrier(const XcdBarrier& b, unsigned* lb) {
    asm volatile("s_waitcnt vmcnt(0)" ::: "memory");
    __syncthreads();
    if (threadIdx.x == 0) {
        __builtin_amdgcn_s_waitcnt(0);
        const unsigned nloc = b.st[0];
        const unsigned old = xb_add(&lb[64 * b.x], 1u), gen = old / nloc;
        if (old + 1u == (gen + 1u) * nloc) xb_add(&lb[1024 + 64 * b.x], 1u);
        else XB_SPIN(xb_ld(&lb[1024 + 64 * b.x]) == gen, b.bar);
        __builtin_amdgcn_fence(__ATOMIC_ACQUIRE, "agent");
        asm volatile("s_waitcnt vmcnt(0)" ::: "memory");
    }
    __syncthreads();
}

template <bool GU>
__device__ __forceinline__ void transpose_item(const float* W, int K, int N, bf16* WT, const float* gain, LAS float* scr, int item, int lane) {
    const int nkb2 = K / 128, w8 = item & 7, I = item >> 3, kb = 2 * (I % nkb2) + (w8 & 1), nb = 4 * (I / nkb2) + (w8 >> 1), k0 = 64 * kb, n0 = 64 * nb;
    const int d0 = GU ? (((n0 % DFF) >> 7) * 256 + (n0 >= DFF ? 128 : 0) + (n0 & 127)) : n0;
    const int lr = lane >> 4, lc = (lane & 15) * 4;
    f32x4 v[16];
#pragma unroll
    for (int j = 0; j < 16; ++j) v[j] = __builtin_nontemporal_load((const f32x4*)(W + (size_t)(k0 + lr + 4 * j) * N + n0 + lc));
#pragma unroll
    for (int j = 0; j < 16; ++j) *(LAS f32x4*)(scr + (lr + 4 * j) * 68 + lc) = v[j];
    LDS_WAIT(); asm volatile("" ::: "memory");
    const int c = lane & 7;
    f32x4 g0 = (f32x4){1.f, 1.f, 1.f, 1.f}, g1 = g0;
    if (gain) { g0 = *(const f32x4*)(gain + k0 + 8 * c); g1 = *(const f32x4*)(gain + k0 + 8 * c + 4); }
#pragma unroll
    for (int j = 0; j < 8; ++j) { const int n = (lane >> 3) + 8 * j; const LAS float* s = scr + (8 * c) * 68 + n;
        u32x4 o; o.x = pk2(s[0 * 68] * g0[0], s[1 * 68] * g0[1]); o.y = pk2(s[2 * 68] * g0[2], s[3 * 68] * g0[3]); o.z = pk2(s[4 * 68] * g1[0], s[5 * 68] * g1[1]); o.w = pk2(s[6 * 68] * g1[2], s[7 * 68] * g1[3]);
        *(u32x4*)(WT + (size_t)(d0 + n) * K + k0 + 8 * c) = o; }
    LDS_WAIT(); asm volatile("" ::: "memory");
}
template <bool GU = false>
__device__ __forceinline__ void convert_matrix(const float* W, int K, int N, bf16* WT, const float* gain, lds_t* lds, int gw, int ngw, int wave, int lane) {
    LAS float* scr = (LAS float*)(lds + wave * 17408);
    const int nitems = (K / 64) * (N / 64);
    for (int it = gw; it < nitems; it += ngw) transpose_item<GU>(W, K, N, WT, gain, scr, it, lane);
}
__device__ __forceinline__ void x_row_prologue(const float* xrow, bf16* orow, pg8::rsq_t* rowsq, int lane) {
    const f32x4* xr = (const f32x4*)xrow + lane; f32x4 v[8]; float s = 0.f;
#pragma unroll
    for (int j = 0; j < 8; ++j) { v[j] = __builtin_nontemporal_load(xr + 64 * j); s += (v[j].x * v[j].x + v[j].y * v[j].y) + (v[j].z * v[j].z + v[j].w * v[j].w); }
    s = wave_sum(s);
    u32x2* o8 = (u32x2*)orow + lane;
#pragma unroll
    for (int j = 0; j < 8; ++j) { u32x2 w; w.x = pk2(v[j].x, v[j].y); w.y = pk2(v[j].z, v[j].w); o8[64 * j] = w; }
    if (lane == 0) *rowsq = (pg8::rsq_t)(s * pg8::RSQ_FIX);
}
__device__ __forceinline__ void norm_row_bf16(const float* xrow, const float* gain, bf16* orow, int lane) {
    const f32x4* xr = (const f32x4*)xrow + lane; const f32x4* gr = (const f32x4*)gain + lane; f32x4 v[8]; float s = 0.f;
#pragma unroll
    for (int j = 0; j < 8; ++j) { v[j] = xr[64 * j]; s += (v[j].x * v[j].x + v[j].y * v[j].y) + (v[j].z * v[j].z + v[j].w * v[j].w); }
    const float rs = __builtin_amdgcn_rsqf(wave_sum(s) * (1.f / DM) + pg8::RMS_EPS);
    u32x2* o8 = (u32x2*)orow + lane;
#pragma unroll
    for (int j = 0; j < 8; ++j) { const f32x4 g = gr[64 * j]; u32x2 w; w.x = pk2(v[j].x * rs * g.x, v[j].y * rs * g.y); w.y = pk2(v[j].z * rs * g.z, v[j].w * rs * g.w); o8[64 * j] = w; }
}

namespace att {
__device__ __forceinline__ int crow(int r, int hi) { return (r & 3) + 8 * (r >> 2) + 4 * hi; }
#define KSWZ(RB, row, colB) ((row) * (RB) + ((colB) ^ (((row) & 7) << 4)))
__device__ __forceinline__ int v_st(int k, int c) { const int kk = (k & ~0xC) | ((k & 4) << 1) | ((k & 8) >> 1); return ((kk >> 3) * 4 + (c >> 5)) * 512 + ((kk & 7) * 32 + (c & 31)) * 2; }
__device__ __forceinline__ int v_rd_base(int lane) { return ((lane & 3) << 3) | (((lane >> 2) & 3) << 6) | (((lane >> 4) & 1) << 5) | (((lane >> 5) & 1) << 8); }
constexpr int v_rd_off(int d0, int ks, int half) { return d0 * 512 + ks * 4096 + half * 2048; }
template <int OFF> __device__ __forceinline__ s16x4 tr_read(int vb) {
    s16x4 r; asm volatile("ds_read_b64_tr_b16 %0, %1 offset:%2" : "=&v"(r) : "v"(vb), "i"(OFF) : "memory"); return r;
}
template <int D0> __device__ __forceinline__ void pv_one(f32x16& od, int vb, bf16x8 pa0, bf16x8 pa1, bf16x8 pa2, bf16x8 pa3) {
    const s16x4 l0 = tr_read<v_rd_off(D0, 0, 0)>(vb), h0 = tr_read<v_rd_off(D0, 0, 1)>(vb), l1 = tr_read<v_rd_off(D0, 1, 0)>(vb), h1 = tr_read<v_rd_off(D0, 1, 1)>(vb);
    const s16x4 l2 = tr_read<v_rd_off(D0, 2, 0)>(vb), h2 = tr_read<v_rd_off(D0, 2, 1)>(vb), l3 = tr_read<v_rd_off(D0, 3, 0)>(vb), h3 = tr_read<v_rd_off(D0, 3, 1)>(vb);
    asm volatile("s_waitcnt lgkmcnt(0)" ::: "memory"); SBAR();
#define PK(L, H) (bf16x8){L[0], L[1], L[2], L[3], H[0], H[1], H[2], H[3]}
    od = __builtin_amdgcn_mfma_f32_32x32x16_bf16(pa0, PK(l0, h0), od, 0, 0, 0);
    od = __builtin_amdgcn_mfma_f32_32x32x16_bf16(pa1, PK(l1, h1), od, 0, 0, 0);
    od = __builtin_amdgcn_mfma_f32_32x32x16_bf16(pa2, PK(l2, h2), od, 0, 0, 0);
    od = __builtin_amdgcn_mfma_f32_32x32x16_bf16(pa3, PK(l3, h3), od, 0, 0, 0);
#undef PK
}
__device__ __forceinline__ void pv_d0(f32x16* o, int vb, bf16x8 pa0, bf16x8 pa1, bf16x8 pa2, bf16x8 pa3) {
    pv_one<0>(o[0], vb, pa0, pa1, pa2, pa3); pv_one<1>(o[1], vb, pa0, pa1, pa2, pa3); pv_one<2>(o[2], vb, pa0, pa1, pa2, pa3); pv_one<3>(o[3], vb, pa0, pa1, pa2, pa3);
}
template <int ND0> __device__ __forceinline__ void qkt(f32x16& p0, f32x16& p1, const lds_t* Ks, const bf16x8* qr, int r32, int hi) {
    constexpr int RB = ND0 * 32;
    p0 = f32x16{}; p1 = f32x16{};
#pragma unroll
    for (int d0 = 0; d0 < ND0; ++d0) { const int cb = (d0 * 16 + hi * 8) * 2;
        const bf16x8 b0 = *(const LAS bf16x8*)(Ks + KSWZ(RB, r32, cb));
        const bf16x8 b1 = *(const LAS bf16x8*)(Ks + KSWZ(RB, 32 + r32, cb));
        p0 = __builtin_amdgcn_mfma_f32_32x32x16_bf16(b0, qr[d0], p0, 0, 0, 0);
        p1 = __builtin_amdgcn_mfma_f32_32x32x16_bf16(b1, qr[d0], p1, 0, 0, 0); }
}
__device__ __forceinline__ void pack_p(const f32x16& p0, const f32x16& p1, bf16x8& pa0, bf16x8& pa1, bf16x8& pa2, bf16x8& pa3) {
#define PK4(P, BASE, OUT) do { unsigned a0 = pk2(P[BASE + 0], P[BASE + 1]), a1 = pk2(P[BASE + 2], P[BASE + 3]);   \
    unsigned b0 = pk2(P[BASE + 4], P[BASE + 5]), b1 = pk2(P[BASE + 6], P[BASE + 7]);                              \
    auto r0 = __builtin_amdgcn_permlane32_swap(a0, b0, false, false); auto r1 = __builtin_amdgcn_permlane32_swap(a1, b1, false, false); \
    u32x4 w = {r0[0], r1[0], r0[1], r1[1]}; OUT = __builtin_bit_cast(bf16x8, w); } while (0)
    PK4(p0, 0, pa0); PK4(p0, 8, pa1); PK4(p1, 0, pa2); PK4(p1, 8, pa3);
#undef PK4
}

constexpr int OST_PITCH = 272, OST_BYTES = 32 * OST_PITCH;
__device__ __forceinline__ void stage_o_tile(lds_t* st, const f32x16* o, const float* rsc, const float* csc, int r32, int hi) {
#pragma unroll
    for (int r = 0; r < 16; ++r) { lds_t* rp = st + crow(r, hi) * OST_PITCH + r32 * 2;
#pragma unroll
        for (int d0 = 0; d0 < 4; ++d0) *(LAS unsigned short*)(rp + d0 * 64) = (unsigned short)(pk2(o[d0][r] * rsc[r] * csc[d0], 0.f) & 0xffffu); }
    LDS_WAIT();
}
template <bool MOBA>
__device__ __forceinline__ void attn_unit(int wave_s, const bf16* Qb, int ldq, const bf16* Kb, const bf16* Vb, int ldk, bf16* Ob, int ldo, int NT, int own, float slope2, const float* kmean_g, lds_t* lds) {
    int tid_ = mk_tid(wave_s);
    const int tid = tid_, wid = tid >> 6, lane = tid & 63, r32 = lane & 31, hi = lane >> 5;
    lds_t* V_lds = lds; lds_t* K_lds = lds + 49152;
    LAS float* wsf = (LAS float*)(lds + 98304) + wid * 64; LAS float* li_l = wsf; LAS float* al_l = wsf + 32;
    LAS float* km_l = (LAS float*)(lds + 98304 + 2048);
    constexpr float C = 0.088388347648318440f * 1.4426950408889634f;
    constexpr float THR2 = 8.0f;
    const float NEG_INF = -__builtin_inff(), POS_INF = __builtin_inff();
    bf16x8 qr[8];
    { const bf16* Qw = Qb + (size_t)(wid * 32 + r32) * ldq + hi * 8;
#pragma unroll
      for (int d0 = 0; d0 < 8; ++d0) qr[d0] = *(const bf16x8*)(Qw + d0 * 16); }
    unsigned selmask = 0xffffffffu; int qrel = 0;
    if constexpr (MOBA) {
        for (int i = tid; i < 2048; i += NTHREADS) km_l[i] = kmean_g[i];
        __syncthreads();
        float g[16];
#pragma unroll
        for (int j = 0; j < 16; ++j) g[j] = 0.f;
        const bf16* Qg = Qb + (size_t)(wid * 32 + r32) * ldq + hi * 8;
#pragma unroll 1
        for (int d0 = 0; d0 < 8; ++d0) { const u32x4 qw = *(const u32x4*)(Qg + d0 * 16);
            const float q0 = bflo(qw.x), q1 = bfhi(qw.x), q2 = bflo(qw.y), q3 = bfhi(qw.y), q4 = bflo(qw.z), q5 = bfhi(qw.z), q6 = bflo(qw.w), q7 = bfhi(qw.w);
#pragma unroll
            for (int j = 0; j < 16; ++j) { const f32x4 a = *(const LAS f32x4*)(km_l + j * 128 + d0 * 16 + hi * 8), b = *(const LAS f32x4*)(km_l + j * 128 + d0 * 16 + hi * 8 + 4);
                g[j] += (q0 * a.x + q1 * a.y) + (q2 * a.z + q3 * a.w) + (q4 * b.x + q5 * b.y) + (q6 * b.z + q7 * b.w); } }
#pragma unroll
        for (int j = 0; j < 16; ++j) g[j] += __shfl_xor(g[j], 32);
        selmask = 0u;
#pragma unroll
        for (int t = 0; t < 3; ++t) { float best = NEG_INF; int bi = -1;
#pragma unroll
            for (int j = 0; j < 16; ++j) { const bool ok = (j < own) && !((selmask >> j) & 1u) && (g[j] > best); best = ok ? g[j] : best; bi = ok ? j : bi; }
            if (bi >= 0) selmask |= 1u << bi; }
        selmask |= 1u << own;
        qrel = wid * 32 + r32;
    }
    const int vb0 = (int)(unsigned)(size_t)V_lds + v_rd_base(lane);
    const int wu = __builtin_amdgcn_readfirstlane(wid);
    unsigned koff[2], voff[2];
#pragma unroll
    for (int i = 0; i < 2; ++i) { const int pc = i * 8 + wid; const int row = pc * 4 + (lane >> 4), chunk = (lane & 15) ^ (row & 7); koff[i] = (unsigned)(row * ldk + chunk * 8);
        const int st = pc * 2 + (lane >> 5), kk = (st >> 2) * 8 + ((lane & 31) >> 2), k = (kk & ~0xC) | ((kk & 4) << 1) | ((kk & 8) >> 1), c = (st & 3) * 32 + (lane & 3) * 8; voff[i] = (unsigned)(k * ldk + c); }
    const float s32 = MOBA ? slope2 * 32.f : 0.f, sh4 = MOBA ? slope2 * (float)(4 * hi) : 0.f;
#define tk(j) (MOBA ? ((j) < 4 ? own * 256 + 64 * (j) : (own - 1 - (((j) - 4) >> 2)) * 256 + 64 * (((j) - 4) & 3)) : 64 * (j))
#define SDMA(k0, b) do { const bf16* kt_ = Kb + (size_t)(k0) * ldk; const bf16* vt_ = Vb + (size_t)(k0) * ldk; _Pragma("unroll") for (int i_ = 0; i_ < 2; ++i_) { \
    __builtin_amdgcn_global_load_lds((const unsigned*)(kt_ + koff[i_]), (LAS unsigned*)(K_lds + (b) * 16384 + (i_ * 8 + wu) * 1024), 16, 0, 0); \
    __builtin_amdgcn_global_load_lds((const unsigned*)(vt_ + voff[i_]), (LAS unsigned*)(V_lds + (b) * 16384 + (i_ * 8 + wu) * 1024), 16, 0, 0); } } while (0)
    float m_reg = -1e30f, l_reg = 0.f; f32x16 o[4] = {};
    SDMA(tk(0), 0); if (NT > 1) { SDMA(tk(1), 1); asm volatile("s_waitcnt vmcnt(4)" ::: "memory"); } else VM_WAIT();
    WG_BAR();
    int cur = 0, nx1 = 1, nx2 = 2;
    for (int j = 0; j < NT; ++j) {
        if (j + 2 < NT) SDMA(tk(j + 2), nx2);
        bool active = true, partial = false, rv = true; float base = 0.f;
        if constexpr (MOBA) {
            const int k0 = tk(j), blk = k0 >> 8, krel = k0 - own * 256;
            rv = (selmask >> blk) & 1u; base = slope2 * (float)krel;
            if (blk == own) { active = krel <= wu * 32 + 31; partial = krel + 63 > wu * 32; }
            else active = __any(rv);
        }
        if (active) {
            f32x16 p0, p1;
            qkt<8>(p0, p1, K_lds + cur * 16384, qr, r32, hi);
#pragma unroll
            for (int r = 0; r < 16; ++r) { const float scr = MOBA ? fmaf(slope2, (float)((r & 3) + 8 * (r >> 2)), sh4) : 0.f; p0[r] = fmaf(p0[r], C, scr); p1[r] = fmaf(p1[r], C, scr); }
            if constexpr (MOBA) { if (partial) { const int lim = qrel - (tk(j) - own * 256);
#pragma unroll
                for (int r = 0; r < 16; ++r) { const int ko = crow(r, hi); p0[r] = (ko <= lim) ? p0[r] : NEG_INF; p1[r] = (ko + 32 <= lim) ? p1[r] : NEG_INF; } } }
            float mx0 = p0[0], mx1 = p1[0];
#pragma unroll
            for (int r = 1; r < 16; ++r) { mx0 = fmaxf(mx0, p0[r]); mx1 = fmaxf(mx1, p1[r]); }
            float pmax = fmaxf(mx0, mx1 + s32) + base; pmax = rv ? pmax : NEG_INF;
            { auto rr = __builtin_amdgcn_permlane32_swap(__float_as_uint(pmax), __float_as_uint(pmax), false, false); pmax = fmaxf(__uint_as_float(rr[0]), __uint_as_float(rr[1])); }
            float alpha = 1.f;
            if (!__all(pmax - m_reg <= THR2)) {
                const float mn = fmaxf(m_reg, pmax); alpha = __builtin_amdgcn_exp2f(m_reg - mn); m_reg = mn;
                if (hi == 0) al_l[r32] = alpha; LDS_WAIT();
#pragma unroll
                for (int r = 0; r < 16; ++r) { const float a = al_l[crow(r, hi)];
#pragma unroll
                    for (int d = 0; d < 4; ++d) o[d][r] *= a; }
            }
            const float ms0 = rv ? (m_reg - base) : POS_INF, ms1 = ms0 - s32;
            float ps = 0.f;
#pragma unroll
            for (int r = 0; r < 16; ++r) { p0[r] = __builtin_amdgcn_exp2f(p0[r] - ms0); p1[r] = __builtin_amdgcn_exp2f(p1[r] - ms1); ps += p0[r] + p1[r]; }
            { auto rr = __builtin_amdgcn_permlane32_swap(__float_as_uint(ps), __float_as_uint(ps), false, false); ps = __uint_as_float(rr[0]) + __uint_as_float(rr[1]); }
            l_reg = l_reg * alpha + ps;
            bf16x8 pa0, pa1, pa2, pa3; pack_p(p0, p1, pa0, pa1, pa2, pa3);
            pv_d0(o, vb0 + cur * 16384, pa0, pa1, pa2, pa3);
        }
        if (j + 2 < NT) asm volatile("s_waitcnt vmcnt(4)" ::: "memory"); else VM_WAIT();
        WG_BAR();
        { const int t = cur; cur = nx1; nx1 = nx2; nx2 = t; }
    }
#undef SDMA
#undef tk
    if (hi == 0) li_l[r32] = l_reg; LDS_WAIT();
    { int hi_e = hi, r32_e = r32, wid_e = wid, lane_e = lane; asm volatile("" : "+v"(hi_e), "+v"(r32_e), "+v"(wid_e), "+v"(lane_e));
      LAS float* li_e = (LAS float*)(lds + 98304) + wid_e * 64; float rsc[16]; const float one[4] = {1.f, 1.f, 1.f, 1.f};
#pragma unroll
      for (int r = 0; r < 16; ++r) rsc[r] = __builtin_amdgcn_rcpf(li_e[crow(r, hi_e)]);
      lds_t* stg = lds + wid_e * OST_BYTES;
      stage_o_tile(stg, o, rsc, one, r32_e, hi_e);
      bf16* Ow = Ob + (size_t)(wid_e * 32) * ldo;
#pragma unroll
      for (int j = 0; j < 8; ++j) { const int idx = j * 64 + lane_e, row = idx >> 4, ch = idx & 15;
          *(u32x4*)(Ow + (size_t)row * ldo + ch * 8) = *(const LAS u32x4*)(stg + row * OST_PITCH + ch * 16); } }
    __syncthreads();
}

__device__ __forceinline__ void ret_unit(int wave_s, const bf16* proj, int ldp, const bf16* Sb, const float* gn, bf16* cat, int b, int h, int n, float lg2g, lds_t* lds) {
    int tid_ = mk_tid(wave_s);
    const int tid = tid_, wid = tid >> 6, lane = tid & 63, r32 = lane & 31, hi = lane >> 5, wr = wid & 3, wc = wid >> 2;
    LAS float* T = (LAS float*)(lds + 131072);
    const size_t R0 = (size_t)b * SEQ + (size_t)n * RET_C;
    bf16x8 qr[16];
    { const bf16* Qw = proj + (R0 + wr * 32 + r32) * ldp + h * 256 + hi * 8;
#pragma unroll
      for (int d0 = 0; d0 < 16; ++d0) qr[d0] = *(const bf16x8*)(Qw + d0 * 16); }
    const int vbl = (int)(unsigned)(size_t)lds + wc * 16384 + v_rd_base(lane);
    const int wu = __builtin_amdgcn_readfirstlane(wid);
    unsigned koff[4], voff[4], soff[4];
#pragma unroll
    for (int i = 0; i < 4; ++i) { const int pc = i * 8 + wid; const int row = pc * 2 + (lane >> 5), chunk = (lane & 31) ^ (row & 7); koff[i] = (unsigned)(row * ldp + chunk * 8);
        const int img = pc >> 4, st = (pc & 15) * 2 + (lane >> 5), kk = (st >> 2) * 8 + ((lane & 31) >> 2), k = (kk & ~0xC) | ((kk & 4) << 1) | ((kk & 8) >> 1), c = img * 128 + (st & 3) * 32 + (lane & 3) * 8;
        voff[i] = (unsigned)(k * ldp + c); soff[i] = (unsigned)(k * 256 + c); }
    const bf16* Kg = proj + R0 * ldp + MIXW + h * 256; const bf16* Vg = proj + R0 * ldp + 2 * MIXW + h * 256;
#define RET_JOB_S(t) do { _Pragma("unroll") for (int i_ = 0; i_ < 4; ++i_) __builtin_amdgcn_global_load_lds((const unsigned*)(Sb + (size_t)(64 * (t)) * 256 + soff[i_]), (LAS unsigned*)(lds + (t) * 32768 + (i_ * 8 + wu) * 1024), 16, 0, 0); } while (0)
#define RET_JOB_K(kt, buf) do { _Pragma("unroll") for (int i_ = 0; i_ < 4; ++i_) __builtin_amdgcn_global_load_lds((const unsigned*)(Kg + (size_t)(64 * (kt)) * ldp + koff[i_]), (LAS unsigned*)(lds + (buf) * 32768 + (i_ * 8 + wu) * 1024), 16, 0, 0); } while (0)
#define RET_JOB_V(kt, buf) do { _Pragma("unroll") for (int i_ = 0; i_ < 4; ++i_) __builtin_amdgcn_global_load_lds((const unsigned*)(Vg + (size_t)(64 * (kt)) * ldp + voff[i_]), (LAS unsigned*)(lds + (buf) * 32768 + (i_ * 8 + wu) * 1024), 16, 0, 0); } while (0)
#define RET_WAIT(nleft) do { asm volatile("s_waitcnt vmcnt(" #nleft ")" ::: "memory"); WG_BAR(); } while (0)
#define RET_KV(kt, kbuf, vbuf) do { if (64 * (kt) <= 32 * wr + 31) { f32x16 p0, p1; qkt<16>(p0, p1, lds + (kbuf) * 32768, qr, r32, hi); const int c = wr * 32 + r32; \
        _Pragma("unroll") for (int r = 0; r < 16; ++r) { const int m0 = 64 * (kt) + crow(r, hi); p0[r] = (c >= m0) ? p0[r] : 0.f; p1[r] = (c >= m0 + 32) ? p1[r] : 0.f; } \
        bf16x8 pa0, pa1, pa2, pa3; pack_p(p0, p1, pa0, pa1, pa2, pa3); pv_d0(o, vbl + (vbuf) * 32768, pa0, pa1, pa2, pa3); } } while (0)
    f32x16 o[4] = {};
    if (n > 0) {
        RET_JOB_S(0); RET_JOB_S(1); RET_JOB_S(2); RET_JOB_S(3);
        RET_WAIT(12);                 pv_d0(o, vbl + 0 * 32768, qr[0], qr[1], qr[2], qr[3]);
        RET_WAIT(8);  RET_JOB_K(0, 0); pv_d0(o, vbl + 1 * 32768, qr[4], qr[5], qr[6], qr[7]);
        RET_WAIT(8);  RET_JOB_V(0, 1); pv_d0(o, vbl + 2 * 32768, qr[8], qr[9], qr[10], qr[11]);
        RET_WAIT(8);  RET_JOB_K(1, 2); pv_d0(o, vbl + 3 * 32768, qr[12], qr[13], qr[14], qr[15]);
        { const float g128 = __builtin_amdgcn_exp2f(128.f * lg2g);
#pragma unroll
          for (int d = 0; d < 4; ++d)
#pragma unroll
              for (int r = 0; r < 16; ++r) o[d][r] *= g128; }
        RET_WAIT(4);  RET_JOB_V(1, 3); RET_KV(0, 0, 1);
        RET_WAIT(0);                  RET_KV(1, 2, 3);
    } else {
        RET_JOB_K(0, 0); RET_JOB_V(0, 1); RET_JOB_K(1, 2); RET_JOB_V(1, 3);
        RET_WAIT(8); RET_KV(0, 0, 1);
        RET_WAIT(0); RET_KV(1, 2, 3);
    }
#undef RET_JOB_S
#undef RET_JOB_K
#undef RET_JOB_V
#undef RET_WAIT
#undef RET_KV
    int hi_e = hi, r32_e = r32, wr_e = wr, wc_e = wc, wid_e = wid, lane_e = lane; asm volatile("" : "+v"(hi_e), "+v"(r32_e), "+v"(wr_e), "+v"(wc_e), "+v"(wid_e), "+v"(lane_e));
    float rsc[16];
#pragma unroll
    for (int r = 0; r < 16; ++r) { const float f = __builtin_amdgcn_exp2f(lg2g * (float)(wr_e * 32 + crow(r, hi_e) - 127)); float s = 0.f;
#pragma unroll
        for (int d = 0; d < 4; ++d) { o[d][r] *= f; s += o[d][r] * o[d][r]; }
        s += __shfl_xor(s, 1); s += __shfl_xor(s, 2); s += __shfl_xor(s, 4); s += __shfl_xor(s, 8); s += __shfl_xor(s, 16); rsc[r] = s; }
    if (r32_e == 0) {
#pragma unroll
        for (int r = 0; r < 16; ++r) T[wc_e * 128 + wr_e * 32 + crow(r, hi_e)] = rsc[r]; }
    __syncthreads();
    float gnv[4];
    const int colb = h * 256 + wc_e * 128;
#pragma unroll
    for (int d = 0; d < 4; ++d) gnv[d] = gn[colb + d * 32 + r32_e];
#pragma unroll
    for (int r = 0; r < 16; ++r) { const int rl = wr_e * 32 + crow(r, hi_e); rsc[r] = __builtin_amdgcn_rsqf((T[rl] + T[128 + rl]) * (1.f / 256.f) + pg8::RMS_EPS); }
    lds_t* stg = lds + wid_e * OST_BYTES;
    stage_o_tile(stg, o, rsc, gnv, r32_e, hi_e);
#pragma unroll
    for (int j = 0; j < 8; ++j) { const int idx = j * 64 + lane_e, row = idx >> 4, ch = idx & 15;
        const u32x4 yv = *(const LAS u32x4*)(stg + row * OST_PITCH + ch * 16);
        const size_t grow = R0 + wr_e * 32 + row;
        const u32x4 gv = *(const u32x4*)(proj + grow * ldp + 3 * MIXW + colb + ch * 8);
        u32x4 ov;
#pragma unroll
        for (int q = 0; q < 4; ++q) ov[q] = pk2(bflo(yv[q]) * silu_f(bflo(gv[q])), bfhi(yv[q]) * silu_f(bfhi(gv[q])));
        *(u32x4*)(cat + grow * DM + colb + ch * 8) = ov; }
    __syncthreads();
}

__device__ __forceinline__ s16x4 tr_read_v(int addr) { s16x4 r; asm volatile("ds_read_b64_tr_b16 %0, %1" : "=&v"(r) : "v"(addr) : "memory"); return r; }
__device__ __forceinline__ void scan_item(int wave_s, const bf16* proj, int ldp, bf16* Sbuf, int b, int h, int es, float lg2g, lds_t* lds) {
    int tid_ = mk_tid(wave_s);
    const int tid = tid_, wid = tid >> 6, lane = tid & 63, r32 = lane & 31, hi = lane >> 5;
    const int li = lane & 15, gp = (lane >> 4) & 1, wu = __builtin_amdgcn_readfirstlane(wid);
    const int lbase = (int)(unsigned)(size_t)lds;
    const int kb = lbase + (8 * hi + (li >> 2)) * 512 + (((4 * wid + 2 * gp + ((li & 3) >> 1)) ^ (((li >> 2) & 3) << 2)) * 16) + (li & 1) * 8;
    const int vb = lbase + 131072 + (8 * hi + (li >> 2)) * 64 + (16 * gp + 4 * (li & 3)) * 2;
    unsigned koff[4];
#pragma unroll
    for (int i = 0; i < 4; ++i) { const int pc = i * 8 + wid, row = 2 * pc + (lane >> 5), gch = (lane & 31) ^ ((row & 3) << 2); koff[i] = (unsigned)(row * ldp + gch * 8); }
    const unsigned voff = (unsigned)((16 * (wid & 3) + (lane >> 2)) * ldp + (lane & 3) * 8);
    const bf16* Kg = proj + ((size_t)b * SEQ) * ldp + MIXW + h * 256; const bf16* Vg = proj + ((size_t)b * SEQ) * ldp + 2 * MIXW + h * 256 + 32 * es;
    const float g128 = __builtin_amdgcn_exp2f(128.f * lg2g);
    bf16* Sp0 = Sbuf + ((size_t)((b * RET_H + h) * RET_NC) * 256) * 256 + (size_t)(32 * wid) * 256 + 32 * es + r32;
    f32x16 acc = {};
#define SCAN_DMA(s) do { const size_t t0_ = (size_t)(64 * (s)) * ldp; const int sl_ = (s) & 3; _Pragma("unroll") for (int i_ = 0; i_ < 4; ++i_) \
        __builtin_amdgcn_global_load_lds((const unsigned*)(Kg + t0_ + koff[i_]), (LAS unsigned*)(lds + sl_ * 32768 + (i_ * 8 + wu) * 1024), 16, 0, 0); \
    __builtin_amdgcn_global_load_lds((const unsigned*)(Vg + t0_ + voff), (LAS unsigned*)(lds + 131072 + sl_ * 4096 + (wu & 3) * 1024), 16, 0, 0); } while (0)
#define SCAN_MMA(sl) do { s16x4 a0_[4], a1_[4], b0_[4], b1_[4]; _Pragma("unroll") for (int ks = 0; ks < 4; ++ks) { \
        a0_[ks] = tr_read_v(kb + (sl) * 32768 + (16 * ks) * 512); a1_[ks] = tr_read_v(kb + (sl) * 32768 + (16 * ks + 4) * 512); \
        b0_[ks] = tr_read_v(vb + (sl) * 4096 + (16 * ks) * 64); b1_[ks] = tr_read_v(vb + (sl) * 4096 + (16 * ks + 4) * 64); } \
        LDS_WAIT(); SBAR();                                          \
        _Pragma("unroll") for (int ks = 0; ks < 4; ++ks) { \
        const bf16x8 A = (bf16x8){a0_[ks][0], a0_[ks][1], a0_[ks][2], a0_[ks][3], a1_[ks][0], a1_[ks][1], a1_[ks][2], a1_[ks][3]}, B = (bf16x8){b0_[ks][0], b0_[ks][1], b0_[ks][2], b0_[ks][3], b1_[ks][0], b1_[ks][1], b1_[ks][2], b1_[ks][3]}; \
        acc = __builtin_amdgcn_mfma_f32_32x32x16_bf16(A, B, acc, 0, 0, 0); } } while (0)
#define SCAN_STORE(n) do { bf16* Sp = Sp0 + (size_t)(n) * 65536; _Pragma("unroll") for (int r = 0; r < 16; ++r) Sp[(size_t)crow(r, hi) * 256] = (bf16)(pk2(acc[r], 0.f) & 0xffffu); } while (0)
    constexpr int NHS = 2 * (RET_NC - 1);
    SCAN_DMA(0); SCAN_DMA(1); SCAN_DMA(2);
#pragma unroll 1
    for (int n = 0; n < RET_NC - 1; ++n) {
        const int s0 = 2 * n;
        if (n == 0) asm volatile("s_waitcnt vmcnt(10)" ::: "memory"); else if (s0 + 2 < NHS) asm volatile("s_waitcnt vmcnt(26)" ::: "memory"); else asm volatile("s_waitcnt vmcnt(21)" ::: "memory");
        WG_BAR();
        if (s0 + 3 < NHS) SCAN_DMA(s0 + 3);
        SCAN_STORE(n);
#pragma unroll
        for (int r = 0; r < 16; ++r) acc[r] *= g128;
        if ((n & 1) == 0) SCAN_MMA(0); else SCAN_MMA(2);
        if (n == 0) asm volatile("s_waitcnt vmcnt(26)" ::: "memory"); else if (s0 + 3 < NHS) asm volatile("s_waitcnt vmcnt(42)" ::: "memory"); else asm volatile("s_waitcnt vmcnt(32)" ::: "memory");
        WG_BAR();
        if (s0 + 4 < NHS) SCAN_DMA(s0 + 4);
        if ((n & 1) == 0) SCAN_MMA(1); else SCAN_MMA(3);
    }
    SCAN_STORE(RET_NC - 1);
#undef SCAN_DMA
#undef SCAN_MMA
#undef SCAN_STORE
}
}

__device__ __forceinline__ int memattn_owned_unit(int x, int r) { return (((x >> 1) * 4 + (r >> 3)) * 16) + 8 * (x & 1) + (r & 7); }

#ifndef MK_PHASE_MASK
#define MK_PHASE_MASK 0xffffffffu
#endif
#define PH(k) ((MK_PHASE_MASK >> (k)) & 1u)
#ifndef MK_DUP_MASK
#define MK_DUP_MASK 0u
#endif
#ifndef WGM_IN
#define WGM_IN 4
#endif
#ifndef WGM_O
#define WGM_O 4
#endif
#ifndef WGM_UP
#define WGM_UP 8
#endif
#ifndef WGM_DOWN
#define WGM_DOWN 4
#endif
#ifndef MK_LOCAL_SEAMS
#define MK_LOCAL_SEAMS 1
#endif
#ifndef MK_PROBE_PRE
#define MK_PROBE_PRE 0
#endif
#ifndef MK_DUP_NULL
#define MK_DUP_NULL 0
#endif
#define DUP(k) ((int)((MK_DUP_MASK >> (k)) & 1u))
struct Args { const float* in[N_IN]; float* out; unsigned char* ws; int lo, hi, one, pad; };
struct LayerP { const float *norm_mix, *w_in, *extra, *w_mem_kv, *w_o, *norm_ffn, *w_up, *conv_w, *conv_b, *w_down; int kind, nin; };
__device__ __forceinline__ LayerP get_layer(const Args& a, int l) {
    LayerP p; const int kind = l % 3; const int base = (l == 0) ? 3 : (l == 1) ? 13 : (l == 2) ? 23 : 32; int i = base;
    p.kind = kind; p.norm_mix = a.in[i++]; p.w_in = a.in[i++]; p.extra = nullptr; if (kind != 2) p.extra = a.in[i++];
    p.w_mem_kv = a.in[i++]; p.w_o = a.in[i++]; p.norm_ffn = a.in[i++]; p.w_up = a.in[i++]; p.conv_w = a.in[i++]; p.conv_b = a.in[i++]; p.w_down = a.in[i++];
    p.nin = (kind == 0) ? 4 * MIXW + MEMW : 3 * MIXW + MEMW; return p;
}

__global__ void __launch_bounds__(NTHREADS, 2) mk_fwd(Args a) {
    extern __shared__ __attribute__((aligned(16))) unsigned char lds_raw[];
    lds_t* lds = (lds_t*)lds_raw;
    volatile LAS unsigned* MISC = (volatile LAS unsigned*)(lds + MISC_OFF);
    const int wave_s = __builtin_amdgcn_readfirstlane((int)threadIdx.x >> 6);
    const int tid = mk_tid(wave_s);
    const int G = gridDim.x, bx = blockIdx.x;
    const int vcu = (G % 8 == 0) ? (bx % 8) * (G / 8) + bx / 8 : bx;
    const int ngw = G * NWAVES;
    unsigned char* ws = a.ws;
    unsigned* ctl = (unsigned*)(ws + WS_CTL);
    pg8::rsq_t* rowsq = (pg8::rsq_t*)(ws + WS_ROWSQ);
    float* kmean = (float*)(ws + WS_KMEAN);
    bf16* WmemT = (bf16*)(ws + WS_WMEMKV);
    bf16* XB = (bf16*)(ws + WS_XB); bf16* MEMN = (bf16*)(ws + WS_MEMN); bf16* MEMKV = (bf16*)(ws + WS_MEMKV);
    bf16* PROJ = (bf16*)(ws + WS_PROJ); bf16* CAT = (bf16*)(ws + WS_CAT); bf16* SBUF = (bf16*)(ws + WS_SBUF);
    bf16* ACT = (bf16*)(ws + WS_ACT); float* HALO = (float*)(ws + WS_HALO);
    float* X = a.out;
    if (tid < 64) MISC[tid] = 0u;
    __syncthreads();
    XcdBarrier bar; bar.bar = ctl + CW_BAR; bar.x = 0; bar.st = nullptr;
    if (a.one) { bar = xcd_barrier_post(ctl + CW_BAR, MISC + 8); if (tid == 0) __hip_atomic_fetch_or(ctl + CW_VER + (bx & 7), 1u << bar.x, __ATOMIC_RELAXED, __HIP_MEMORY_SCOPE_AGENT); }
    bool local_ok = false;
    int step = 0;
#define RUN_STEP (step >= a.lo && step < a.hi)
#define PHASE_IDS() const int tidp = mk_tid(wave_s); const int lanep = tidp & 63; const int wavep = wave_s; const int gwp = vcu * NWAVES + wavep; (void)lanep; (void)gwp
#define SEAM() do { if (a.one) xcd_barrier(bar); ++step; } while (0)
#define SEAM_NOBAR() do { ++step; } while (0)
#define SEAM_LOCAL() do { if (a.one) { if (local_ok) xcd_local_barrier(bar, ctl + CW_LBAR); else xcd_barrier(bar); } ++step; } while (0)

    if (RUN_STEP && PH(0)) for (int rp = 0; rp <= DUP(0); ++rp) {
        PHASE_IDS();
        for (int l = DEPTH - 1; l >= 0; --l) { const LayerP p = get_layer(a, l); unsigned char* wl = ws + WS_WL + (size_t)l * WL_STRIDE;
            convert_matrix(p.w_mem_kv, DM, 2 * MEMW, WmemT + (size_t)l * 1024 * DM, nullptr, lds, gwp, ngw, wavep, lanep);
            convert_matrix(p.w_in, DM, p.nin, (bf16*)(wl + WL_IN), p.norm_mix, lds, gwp, ngw, wavep, lanep);
            convert_matrix(p.w_o, DM, DM, (bf16*)(wl + WL_O), nullptr, lds, gwp, ngw, wavep, lanep);
            convert_matrix<true>(p.w_up, DM, 2 * DFF, (bf16*)(wl + WL_UP), p.norm_ffn, lds, gwp, ngw, wavep, lanep);
            convert_matrix(p.w_down, DFF, DM, (bf16*)(wl + WL_DOWN), nullptr, lds, gwp, ngw, wavep, lanep); }
        { const bool xown = (G == 256);
          for (int m = xown ? (bx & 7) * 2048 + ((bx >> 3) * NWAVES + wavep) : gwp; m < (xown ? (bx & 7) * 2048 + 2048 : M); m += (xown ? 256 : ngw)) x_row_prologue(a.in[0] + (size_t)m * DM, XB + (size_t)m * DM, rowsq + m, lanep); }
        for (int m = gwp; m < MEMROWS; m += ngw) norm_row_bf16(a.in[1] + (size_t)m * DM, a.in[2], MEMN + (size_t)m * DM, lanep);
        for (int i = gwp * 64 + lanep; i < DEPTH * 4 * 2 * DFF; i += ngw * 64) { const int l = i / (4 * 2 * DFF), r = (i / (2 * DFF)) & 3, n = i % (2 * DFF); const LayerP p = get_layer(a, l);
            const float v = (r < 3) ? p.conv_w[(size_t)r * 2 * DFF + n] : p.conv_b[n];
            ((float*)(ws + WS_CONVS))[i] = v * (n < DFF ? -1.4426950408889634f : -0.6931471805599453f); }
    }
    SEAM();
    if (a.one && MK_LOCAL_SEAMS) {
        if (tid == 0) { bool ok = (G == 256);
            for (int r = 0; r < 8; ++r) { const unsigned m = __hip_atomic_load(ctl + CW_VER + r, __ATOMIC_RELAXED, __HIP_MEMORY_SCOPE_AGENT); ok = ok && m != 0u && (m & (m - 1u)) == 0u; }
            MISC[20] = ok ? 1u : 0u; }
        __syncthreads();
        local_ok = MISC[20] != 0u;
    }
    if (RUN_STEP && PH(1)) for (int rp = 0; rp <= DUP(1); ++rp) {
        pg8::Gemm g{MEMN, WmemT, MEMROWS, 4 * 2 * MEMW, DM}; pg8::StaticOrder S; S.init(MEMROWS, 4 * 2 * MEMW, G, (bx + 128) % G);
        pg8::EpiScaleBf16 E{MEMKV, 4 * 2 * MEMW, nullptr, 0, 0, nullptr, lds + 139264};
        pg8::gemm_phase<pg8::EpiScaleBf16, pg8::StaticOrder, true, true>(wave_s, lds, g, S, E);
    }
    SEAM_NOBAR();

#pragma unroll 1
    for (int l = 0; l < DEPTH; ++l) {
        const LayerP p = get_layer(a, l);
        const int kind = p.kind, nin = p.nin;
        pg8::rsq_t* rsq_mix = rowsq + (size_t)(2 * l) * M; pg8::rsq_t* rsq_ffn = rowsq + (size_t)(2 * l + 1) * M; pg8::rsq_t* rsq_next = rowsq + (size_t)(2 * l + 2) * M;
        unsigned char* wl = ws + WS_WL + (size_t)l * WL_STRIDE;
        bf16* WinT = (bf16*)(wl + WL_IN); bf16* WoT = (bf16*)(wl + WL_O); bf16* WupT = (bf16*)(wl + WL_UP); bf16* WdownT = (bf16*)(wl + WL_DOWN);
        if (RUN_STEP && PH(3)) for (int rp = 0; rp <= DUP(3); ++rp) {
            pg8::Gemm g{XB, WinT, M, nin, DM}; pg8::StaticOrder S; S.init(M, nin, G, bx, WGM_IN);
            if (MK_DUP_NULL && rp < DUP(3)) { pg8::EpiNull E0{(float*)(ws + WS_SCRRSQ)}; if (MK_DUP_NULL == 2) g.kst = 0; pg8::gemm_phase<pg8::EpiNull, pg8::StaticOrder, true, true>(wave_s, lds, g, S, E0); continue; }
            pg8::EpiScaleBf16 E{PROJ, nin, rsq_mix, kind == 0 ? 1 : (kind == 2 ? 2 : 0), kind == 0 ? 12 : 6, kmean, lds + 139264};
            pg8::gemm_phase<pg8::EpiScaleBf16, pg8::StaticOrder, true, true>(wave_s, lds, g, S, E);
        }
        SEAM();
        if (RUN_STEP) {
            int bxl = bx; asm volatile("" : "+s"(bxl));
            const bool xdeal = (G == 256); const int xcd = bxl & 7, rank = bxl >> 3;
            if (kind == 0 && PH(4)) for (int rp = 0; rp <= DUP(4); ++rp) {
                if (xdeal) { if (rank < 24) { const int es = rank & 7, b = xcd >> 1, h = 3 * (xcd & 1) + (rank >> 3);
                    att::scan_item(wave_s, PROJ, nin, SBUF, b, h, es, pg8::ret_lg2g(h), lds); __syncthreads(); } }
                else for (int it = bx; it < BATCH * RET_H * 8; it += G) { const int es = it & 7, bh = it >> 3, b = bh / RET_H, h = bh % RET_H;
                    att::scan_item(wave_s, PROJ, nin, SBUF, b, h, es, pg8::ret_lg2g(h), lds); __syncthreads(); }
            }
            if (kind == 0 && PH(9)) for (int v = (xdeal ? (rank >= 24 ? rank - 24 : -1) : bx); v >= 0 && v < (xdeal ? 32 : BATCH * 4 * (SEQ / 256)); v += (xdeal ? 8 : G)) { const int u = xdeal ? memattn_owned_unit(xcd, v) : v, qb = u % (SEQ / 256), bhh = u / (SEQ / 256), b = bhh >> 2, hh = bhh & 3;
                const bf16* Qb = PROJ + ((size_t)b * SEQ + (size_t)qb * 256) * nin + (nin - MEMW) + hh * 128;
                const bf16* Kb = MEMKV + ((size_t)b * MEMT) * 4096 + l * 1024 + hh * 128; const bf16* Vb = Kb + MEMW;
                att::attn_unit<false>(wave_s, Qb, nin, Kb, Vb, 4096, CAT + ((size_t)b * SEQ + (size_t)qb * 256) * DM + MIXW + hh * 128, DM, MEMT / 64, 0, 0.f, nullptr, lds); }
        }
        if (kind == 0) SEAM_LOCAL(); else SEAM_NOBAR();
        if (RUN_STEP) {
            if (kind == 0 && PH(6)) for (int rp = 0; rp <= DUP(6); ++rp) {
                const bool xdeal = (G == 256);
                int bxl = bx; asm volatile("" : "+s"(bxl));
                for (int it = bxl; it < BATCH * RET_H * RET_NC; it += G) { const int n = xdeal ? (bxl >> 3) : it % RET_NC, bh = xdeal ? ((bxl & 7) >> 1) * RET_H + 3 * (bxl & 1) + (it >> 8) : it / RET_NC, b = bh / RET_H, h = bh % RET_H;
                    att::ret_unit(wave_s, PROJ, nin, SBUF + ((size_t)(bh * RET_NC + n) * 256) * 256, p.extra, CAT, b, h, n, pg8::ret_lg2g(h), lds); }
            } else if (kind == 1 && PH(7)) for (int rp = 0; rp <= DUP(7); ++rp) {
                const float* cw = p.extra; PHASE_IDS();
                const bool xown = (G == 256); const size_t id0 = xown ? (size_t)(bx >> 3) * NTHREADS + tidp : (size_t)bx * NTHREADS + tidp, idn = xown ? (size_t)2048 * (MIXW / 8) : (size_t)M * (MIXW / 8), ids = xown ? (size_t)32 * NTHREADS : (size_t)G * NTHREADS;
                for (size_t id = id0; id < idn; id += ids) {
                    const size_t row = (xown ? (size_t)(bx & 7) * 2048 : 0) + id / (MIXW / 8); const int ch = (int)(id % (MIXW / 8)), c0 = ch * 8, t = (int)(row & (SEQ - 1));
                    const bf16* pr = PROJ + row * nin + c0;
                    const u32x4 Bv = *(const u32x4*)pr, C0 = *(const u32x4*)(pr + MIXW), H0 = *(const u32x4*)(pr + 2 * MIXW);
                    u32x4 C1 = {0, 0, 0, 0}, H1 = C1, C2 = C1, H2 = C1;
                    if (t >= 1) { C1 = *(const u32x4*)(pr - nin + MIXW); H1 = *(const u32x4*)(pr - nin + 2 * MIXW); }
                    if (t >= 2) { C2 = *(const u32x4*)(pr - 2 * nin + MIXW); H2 = *(const u32x4*)(pr - 2 * nin + 2 * MIXW); }
                    float w0[8], w1[8], w2[8];
                    { const f32x4 a0 = *(const f32x4*)(cw + c0), a1 = *(const f32x4*)(cw + c0 + 4), b0 = *(const f32x4*)(cw + MIXW + c0), b1 = *(const f32x4*)(cw + MIXW + c0 + 4), d0 = *(const f32x4*)(cw + 2 * MIXW + c0), d1 = *(const f32x4*)(cw + 2 * MIXW + c0 + 4);
#pragma unroll
                      for (int i = 0; i < 4; ++i) { w0[i] = a0[i]; w0[4 + i] = a1[i]; w1[i] = b0[i]; w1[4 + i] = b1[i]; w2[i] = d0[i]; w2[4 + i] = d1[i]; } }
                    u32x4 ov;
#pragma unroll
                    for (int q = 0; q < 4; ++q) {
                        const float ylo = bflo(Bv[q]) * (w0[2 * q] * bflo(C2[q]) * bflo(H2[q]) + w1[2 * q] * bflo(C1[q]) * bflo(H1[q]) + w2[2 * q] * bflo(C0[q]) * bflo(H0[q]));
                        const float yhi = bfhi(Bv[q]) * (w0[2 * q + 1] * bfhi(C2[q]) * bfhi(H2[q]) + w1[2 * q + 1] * bfhi(C1[q]) * bfhi(H1[q]) + w2[2 * q + 1] * bfhi(C0[q]) * bfhi(H0[q]));
                        ov[q] = pk2(ylo, yhi); }
                    *(u32x4*)(CAT + row * DM + c0) = ov;
                }
            } else if (kind == 2 && PH(8)) {
                PHASE_IDS();
                const bool shard = (G % 8 == 0); const int qx = bx & 7;
                const int NQ = shard ? 128 : BATCH * MOBA_H * MOBA_NB + BATCH * 4 * (SEQ / 256);
                unsigned* qhead = ctl + CW_QUEUE + 8 * l + (shard ? qx : 0);
                unsigned nextL = 0u;
                if (tidp == 0) nextL = __hip_atomic_fetch_add(qhead, 1u, __ATOMIC_RELAXED, __HIP_MEMORY_SCOPE_AGENT);
                for (;;) {
                    if (tidp == 0) MISC[16] = nextL;
                    __syncthreads();
                    const int L = (int)MISC[16];
                    __syncthreads();
                    if (L >= NQ) break;
                    if (tidp == 0) nextL = __hip_atomic_fetch_add(qhead, 1u, __ATOMIC_RELAXED, __HIP_MEMORY_SCOPE_AGENT);
                    if (L < (shard ? 96 : BATCH * MOBA_H * MOBA_NB)) {
                        const int qb = shard ? (MOBA_NB - 1) - L / 6 : (MOBA_NB - 1) - L / (BATCH * MOBA_H), bh = shard ? qx + 8 * (L % 6) : L % (BATCH * MOBA_H), b = bh / MOBA_H, h = bh % MOBA_H;
                        const float slope = (h < 8) ? __builtin_amdgcn_exp2f(-(float)(h + 1)) : __builtin_amdgcn_exp2f(-0.5f - (float)(h - 8));
                        const bf16* Qb = PROJ + ((size_t)b * SEQ + (size_t)qb * 256) * nin + h * 128;
                        const bf16* Kb = PROJ + ((size_t)b * SEQ) * nin + MIXW + h * 128; const bf16* Vb = Kb + MIXW;
                        att::attn_unit<true>(wave_s, Qb, nin, Kb, Vb, nin, CAT + ((size_t)b * SEQ + (size_t)qb * 256) * DM + h * 128, DM, 4 * (qb + 1), qb, slope * 1.4426950408889634f,
                                             kmean + (size_t)(b * MOBA_H + h) * MOBA_NB * 128, lds);
                    } else {
                        const int u = shard ? memattn_owned_unit(qx, L - 96) : L - BATCH * MOBA_H * MOBA_NB, qb = u % (SEQ / 256), bhh = u / (SEQ / 256), b = bhh >> 2, hh = bhh & 3;
                        const bf16* Qb = PROJ + ((size_t)b * SEQ + (size_t)qb * 256) * nin + (nin - MEMW) + hh * 128;
                        const bf16* Kb = MEMKV + ((size_t)b * MEMT) * 4096 + l * 1024 + hh * 128; const bf16* Vb = Kb + MEMW;
                        att::attn_unit<false>(wave_s, Qb, nin, Kb, Vb, 4096, CAT + ((size_t)b * SEQ + (size_t)qb * 256) * DM + MIXW + hh * 128, DM, MEMT / 64, 0, 0.f, nullptr, lds);
                    }
                }
            }
            if (PH(9) && kind == 1) for (int rp = 0; rp <= DUP(9); ++rp) for (int v = bx; v < BATCH * 4 * (SEQ / 256); v += G) { const int u = (G == 256) ? memattn_owned_unit(v & 7, v >> 3) : v, qb = u % (SEQ / 256), bhh = u / (SEQ / 256), b = bhh >> 2, hh = bhh & 3;
                const bf16* Qb = PROJ + ((size_t)b * SEQ + (size_t)qb * 256) * nin + (nin - MEMW) + hh * 128;
                const bf16* Kb = MEMKV + ((size_t)b * MEMT) * 4096 + l * 1024 + hh * 128; const bf16* Vb = Kb + MEMW;
                att::attn_unit<false>(wave_s, Qb, nin, Kb, Vb, 4096, CAT + ((size_t)b * SEQ + (size_t)qb * 256) * DM + MIXW + hh * 128, DM, MEMT / 64, 0, 0.f, nullptr, lds); }
        }
        if (kind == 1) SEAM_LOCAL(); else SEAM();
        if (RUN_STEP && PH(10)) for (int rp = 0; rp <= DUP(10); ++rp) { const bool scr = rp < DUP(10);
            pg8::Gemm g{CAT, WoT, M, DM, DM}; pg8::StaticOrder S; S.init(M, DM, G, bx, WGM_O);
            if (MK_DUP_NULL && scr) { pg8::EpiNull E0{(float*)(ws + WS_SCRRSQ)}; pg8::gemm_phase<pg8::EpiNull, pg8::StaticOrder, true, true>(wave_s, lds, g, S, E0); continue; }
            pg8::EpiRes E{XB, scr ? (bf16*)(ws + WS_SCRXB) : XB, scr ? (pg8::rsq_t*)(ws + WS_SCRRSQ) : rsq_ffn};
            pg8::gemm_phase<pg8::EpiRes, pg8::StaticOrder, true, true>(wave_s, lds, g, S, E);
            if (MK_PROBE_PRE && !scr) { pg8::Gemm g2{XB, WupT, M, 2 * DFF, DM}; pg8::StaticOrder S2; S2.init(M, 2 * DFF, G, bx); pg8::EpiNull E0{(float*)(ws + WS_SCRRSQ)}; pg8::gemm_phase<pg8::EpiNull, pg8::StaticOrder, true, true>(wave_s, lds, g2, S2, E0); }
        }
        SEAM_LOCAL();
        if (RUN_STEP && PH(11)) for (int rp = 0; rp <= DUP(11); ++rp) {
            pg8::Gemm g{XB, WupT, M, 2 * DFF, DM}; pg8::StaticOrder S; S.init(M, 2 * DFF, G, bx, WGM_UP);
            if (MK_DUP_NULL && rp < DUP(11)) { pg8::EpiNull E0{(float*)(ws + WS_SCRRSQ)}; pg8::gemm_phase<pg8::EpiNull, pg8::StaticOrder, true, true>(wave_s, lds, g, S, E0); continue; }
            const float* cws = (const float*)(ws + WS_CONVS) + (size_t)l * 4 * 2 * DFF;
            pg8::EpiUpConv E{ACT, DFF, rsq_ffn, cws, cws + 3 * 2 * DFF, HALO, lds + 131072, lds + 139264};
            pg8::gemm_phase<pg8::EpiUpConv, pg8::StaticOrder, true, true>(wave_s, lds, g, S, E);
        }
        SEAM();
        if (RUN_STEP && PH(12)) for (int rp = 0; rp <= DUP(12); ++rp) {
            const float* cw = p.conv_w; const float* cb = p.conv_b; PHASE_IDS();
            constexpr int NCH = DFF / 8, N2 = 2 * DFF;
            const bool xown = (G == 256);
            for (int id = xown ? (bx >> 3) * NTHREADS + tidp : bx * NTHREADS + tidp; id < (xown ? 8 : M / 256) * NCH; id += (xown ? 32 : G) * NTHREADS) {
                const int pm = (xown ? 8 * (bx & 7) : 0) + id / NCH, ch0 = (id % NCH) * 8; if ((pm & 15) == 0) continue;
                const int pn = ch0 >> 7, j = ch0 & 127, gc = pn * 256 + j;
                const float* hp = HALO + (size_t)(pm - 1) * 4 * N2 + 2 * N2 + gc;
                float G4[4][8], U4[4][8];
#pragma unroll
                for (int r = 0; r < 4; ++r) { const f32x4 g0 = *(const f32x4*)(hp + (size_t)r * N2), g1 = *(const f32x4*)(hp + (size_t)r * N2 + 4), u0 = *(const f32x4*)(hp + (size_t)r * N2 + 128), u1 = *(const f32x4*)(hp + (size_t)r * N2 + 132);
#pragma unroll
                    for (int i = 0; i < 4; ++i) { G4[r][i] = g0[i]; G4[r][4 + i] = g1[i]; U4[r][i] = u0[i]; U4[r][4 + i] = u1[i]; } }
                float wg[3][8], wu[3][8], bg[8], bu[8];
#pragma unroll
                for (int k = 0; k < 3; ++k) { const f32x4 a0 = *(const f32x4*)(cw + k * N2 + ch0), a1 = *(const f32x4*)(cw + k * N2 + ch0 + 4), b0 = *(const f32x4*)(cw + k * N2 + DFF + ch0), b1 = *(const f32x4*)(cw + k * N2 + DFF + ch0 + 4);
#pragma unroll
                    for (int i = 0; i < 4; ++i) { wg[k][i] = a0[i]; wg[k][4 + i] = a1[i]; wu[k][i] = b0[i]; wu[k][4 + i] = b1[i]; } }
                { const f32x4 a0 = *(const f32x4*)(cb + ch0), a1 = *(const f32x4*)(cb + ch0 + 4), b0 = *(const f32x4*)(cb + DFF + ch0), b1 = *(const f32x4*)(cb + DFF + ch0 + 4);
#pragma unroll
                  for (int i = 0; i < 4; ++i) { bg[i] = a0[i]; bg[4 + i] = a1[i]; bu[i] = b0[i]; bu[4 + i] = b1[i]; } }
#pragma unroll
                for (int r = 0; r < 2; ++r) { float av[8];
#pragma unroll
                    for (int i = 0; i < 8; ++i) {
                        const float Gv = wg[0][i] * G4[r][i] + wg[1][i] * G4[r + 1][i] + wg[2][i] * G4[r + 2][i] + bg[i];
                        const float Uv = wu[0][i] * U4[r][i] + wu[1][i] * U4[r + 1][i] + wu[2][i] * U4[r + 2][i] + bu[i];
                        av[i] = silu_f(Gv) * Uv; }
                    u32x4 w; w.x = pk2(av[0], av[1]); w.y = pk2(av[2], av[3]); w.z = pk2(av[4], av[5]); w.w = pk2(av[6], av[7]);
                    *(u32x4*)(ACT + ((size_t)pm * 256 + r) * DFF + ch0) = w; }
            }
        }
        SEAM_LOCAL();
        if (RUN_STEP && PH(13)) for (int rp = 0; rp <= DUP(13); ++rp) { const bool scr = rp < DUP(13);
            pg8::Gemm g{ACT, WdownT, M, DM, DFF}; pg8::StaticOrder S; S.init(M, DM, G, bx, WGM_DOWN);
            if (MK_DUP_NULL && scr) { pg8::EpiNull E0{(float*)(ws + WS_SCRRSQ)}; pg8::gemm_phase<pg8::EpiNull, pg8::StaticOrder, true, true>(wave_s, lds, g, S, E0); continue; }
            pg8::EpiRes E{XB, scr ? (bf16*)(ws + WS_SCRXB) : XB, scr ? (pg8::rsq_t*)(ws + WS_SCRRSQ) : rsq_next};
            pg8::gemm_phase<pg8::EpiRes, pg8::StaticOrder, true, true>(wave_s, lds, g, S, E);
        }
        SEAM_LOCAL();
    }
    if (RUN_STEP && PH(14)) {
        const pg8::rsq_t* rsq = rowsq + (size_t)(2 * DEPTH) * M; const float* gfin = a.in[N_IN - 1]; PHASE_IDS();
        const bool xown = (G == 256);
        for (int m = xown ? (bx & 7) * 2048 + ((bx >> 3) * NWAVES + wavep) : gwp; m < (xown ? (bx & 7) * 2048 + 2048 : M); m += (xown ? 256 : ngw)) { const u32x4* xr = (const u32x4*)(XB + (size_t)m * DM) + lanep; f32x4* orow = (f32x4*)(X + (size_t)m * DM) + 2 * lanep; const f32x4* gr = (const f32x4*)gfin + 2 * lanep;
            const float rs = pg8::rsq_scale(rsq, m);
#pragma unroll
            for (int j = 0; j < 4; ++j) { const u32x4 v = xr[64 * j]; const f32x4 g0 = gr[128 * j], g1 = gr[128 * j + 1];
                orow[128 * j] = (f32x4){bflo(v.x) * rs * g0.x, bfhi(v.x) * rs * g0.y, bflo(v.y) * rs * g0.z, bfhi(v.y) * rs * g0.w};
                orow[128 * j + 1] = (f32x4){bflo(v.z) * rs * g1.x, bfhi(v.z) * rs * g1.y, bflo(v.w) * rs * g1.z, bfhi(v.w) * rs * g1.w}; } }
    }
#undef RUN_STEP
#undef SEAM
#undef SEAM_NOBAR
}
constexpr int NSTEPS = 2 + DEPTH * 7 + 1;

#ifndef MK_ONE_LAUNCH
#define MK_ONE_LAUNCH 1
#endif
extern "C" void kernel_launch(void* const* d_in, const int* in_sizes, int n_in, void* d_out, int out_size, void* d_ws, size_t ws_size, hipStream_t stream) {
    static int grid = 0;
    if (grid == 0) {
        if (n_in != N_IN || in_sizes[0] != M * DM || out_size != M * DM || ws_size < (MK_DUP_MASK ? WS_END_PROBE : WS_END)) { fprintf(stderr, "kernel_launch: unexpected shapes (n_in %d, in0 %d, out %d, ws %zu, need %zu); nothing launched\n", n_in, n_in > 0 ? in_sizes[0] : -1, out_size, ws_size, (size_t)WS_END); grid = -1; return; }
        int dev = 0, cus = 0, per_cu = 0;
        if (hipGetDevice(&dev) != hipSuccess || hipDeviceGetAttribute(&cus, hipDeviceAttributeMultiprocessorCount, dev) != hipSuccess) { grid = -1; return; }
        if (hipFuncSetAttribute((const void*)mk_fwd, hipFuncAttributeMaxDynamicSharedMemorySize, LDS_BYTES) != hipSuccess) { fprintf(stderr, "kernel_launch: hipFuncSetAttribute failed\n"); grid = -1; return; }
        if (hipOccupancyMaxActiveBlocksPerMultiprocessor(&per_cu, (const void*)mk_fwd, NTHREADS, LDS_BYTES) != hipSuccess || per_cu < 1) { fprintf(stderr, "kernel_launch: occupancy query says %d blocks per CU\n", per_cu); }
        (void)hipGetLastError();
        grid = cus;
    }
    if (grid < 0) return;
    if (hipMemsetAsync((char*)d_ws + WS_CTL, 0, CTL_ZERO_BYTES, stream) != hipSuccess) { fprintf(stderr, "kernel_launch: memset failed\n"); return; }
    Args a{};
    for (int i = 0; i < N_IN; ++i) a.in[i] = (const float*)d_in[i];
    a.out = (float*)d_out; a.ws = (unsigned char*)d_ws; a.pad = 0;
    if (MK_ONE_LAUNCH) { a.lo = 0; a.hi = 1 << 20; a.one = 1; hipLaunchKernelGGL(mk_fwd, dim3(grid), dim3(NTHREADS), LDS_BYTES, stream, a); }
    else { for (int s = 0; s < NSTEPS; ++s) { a.lo = s; a.hi = s + 1; a.one = 0; hipLaunchKernelGGL(mk_fwd, dim3(grid), dim3(NTHREADS), LDS_BYTES, stream, a); } }
    const hipError_t le = hipPeekAtLastError();
    if (le != hipSuccess) fprintf(stderr, "kernel_launch: launch failed: %s\n", hipGetErrorName(le));
}
```
